# Optimizing an MI355X kernel written in HIP

```python
import math
import jax
import jax.numpy as jnp
from jax import lax
import numpy as np

D_MODEL = 1024
BATCH = 8
SEQ = 2048
DEPTH = 2

PLE_DIM = 256
N_EVEN = (DEPTH + 1) // 2
N_ODD = DEPTH // 2
SSD_HEADS = 16
SSD_HEAD_DIM = 64
SSD_INNER = SSD_HEADS * SSD_HEAD_DIM
SSD_GROUPS = 2
SSD_HPG = SSD_HEADS // SSD_GROUPS
SSD_STATE = 128
SSD_CONV = 4
SSD_CHUNK = 128
SSD_XBC = SSD_INNER + 2 * SSD_GROUPS * SSD_STATE
SC_DIM = 1024
SC_CONV = 3
MIX_IN = SSD_INNER + SSD_XBC + SSD_HEADS + 3 * SC_DIM
MIX_OUT = SSD_INNER + SC_DIM
ATTN_HEADS = 16
ATTN_KV_HEADS = 4
ATTN_GROUP = ATTN_HEADS // ATTN_KV_HEADS
ATTN_HEAD_DIM = 64
WINDOW = 128
ATTN_BLOCK = 128
QKV_DIM = (ATTN_HEADS + 2 * ATTN_KV_HEADS) * ATTN_HEAD_DIM
D_FF = ((8 * D_MODEL + 3 * 256 - 1) // (3 * 256)) * 256
ALPHA = (2 * DEPTH) ** 0.25
BETA = (8 * DEPTH) ** -0.25
LN_EPS = 1e-5
RMS_EPS = 1e-5

kernel_name = 'hybrid_ssd_shortconv_swa_deepnorm'


def layer_norm(x, g, b):
    xf = x.astype(jnp.float32)
    mu = jnp.mean(xf, axis=-1, keepdims=True)
    xc = xf - mu
    var = jnp.mean(xc * xc, axis=-1, keepdims=True)
    return (xc * lax.rsqrt(var + LN_EPS) * g.astype(jnp.float32) + b.astype(jnp.float32)).astype(x.dtype)


def causal_dwconv(x, w):
    k, c = w.shape
    return lax.conv_general_dilated(
        x, w[:, None, :].astype(x.dtype), window_strides=(1,), padding=[(k - 1, 0)],
        dimension_numbers=('NWC', 'WIO', 'NWC'), feature_group_count=c)


def ssd_mixer(z, xbc, dt_raw, conv_w, conv_b, dt_bias, a_log, d_skip, norm_w):
    f32 = jnp.float32
    bsz, seqlen, _ = z.shape
    nc = seqlen // SSD_CHUNK
    xbc = jax.nn.silu(causal_dwconv(xbc, conv_w) + conv_b.astype(xbc.dtype)).astype(f32)
    xs = xbc[..., :SSD_INNER].reshape(bsz, nc, SSD_CHUNK, SSD_GROUPS, SSD_HPG, SSD_HEAD_DIM)
    bm = xbc[..., SSD_INNER:SSD_INNER + SSD_GROUPS * SSD_STATE].reshape(bsz, nc, SSD_CHUNK, SSD_GROUPS, SSD_STATE)
    cm = xbc[..., SSD_INNER + SSD_GROUPS * SSD_STATE:].reshape(bsz, nc, SSD_CHUNK, SSD_GROUPS, SSD_STATE)
    dt = jax.nn.softplus(dt_raw.astype(f32) + dt_bias.astype(f32))
    a = -jnp.exp(a_log.astype(f32))
    dt = dt.reshape(bsz, nc, SSD_CHUNK, SSD_GROUPS, SSD_HPG)
    da = dt * a.reshape(SSD_GROUPS, SSD_HPG)
    xdt = xs * dt[..., None]
    a_cs = jnp.cumsum(da, axis=2)
    seg = a_cs[:, :, :, None] - a_cs[:, :, None, :]
    causal = jnp.tril(jnp.ones((SSD_CHUNK, SSD_CHUNK), dtype=bool))[:, :, None, None]
    decay_ls = jnp.exp(jnp.where(causal, seg, -jnp.inf))
    cb = jnp.einsum('bclgn,bcsgn->bclsg', cm, bm)
    y_diag = jnp.einsum('bclsgr,bcsgrp->bclgrp', cb[..., None] * decay_ls, xdt)
    decay_to_end = jnp.exp(a_cs[:, :, -1:] - a_cs)
    chunk_states = jnp.einsum('bclgn,bclgrp->bcgrpn', bm, xdt * decay_to_end[..., None])
    chunk_decay = jnp.exp(a_cs[:, :, -1])

    def step(h, inp):
        s_c, d_c = inp
        return h * d_c[..., None, None] + s_c, h

    h0 = jnp.zeros((bsz, SSD_GROUPS, SSD_HPG, SSD_HEAD_DIM, SSD_STATE), f32)
    _, h_in = lax.scan(step, h0, (jnp.moveaxis(chunk_states, 1, 0), jnp.moveaxis(chunk_decay, 1, 0)))
    h_in = jnp.moveaxis(h_in, 0, 1)
    y_off = jnp.einsum('bclgn,bcgrpn->bclgrp', cm, h_in) * jnp.exp(a_cs)[..., None]
    y = y_diag + y_off + xs * d_skip.astype(f32).reshape(SSD_GROUPS, SSD_HPG)[:, :, None]
    y = y.reshape(bsz, seqlen, SSD_INNER) * jax.nn.silu(z.astype(f32))
    yg = y.reshape(bsz, seqlen, SSD_GROUPS, SSD_INNER // SSD_GROUPS)
    yg = yg * lax.rsqrt(jnp.mean(yg * yg, axis=-1, keepdims=True) + RMS_EPS)
    return (yg.reshape(bsz, seqlen, SSD_INNER) * norm_w.astype(f32)).astype(z.dtype)


def ssd_shortconv_layer_mixer(x, w_in, conv_w, conv_b, dt_bias, a_log, d_skip, norm_w, sc_conv_w, w_out):
    proj = x @ w_in
    o1 = SSD_INNER
    o2 = o1 + SSD_XBC
    o3 = o2 + SSD_HEADS
    o4 = o3 + SC_DIM
    o5 = o4 + SC_DIM
    z, xbc, dt_raw = proj[..., :o1], proj[..., o1:o2], proj[..., o2:o3]
    sc_b, sc_c, sc_h = proj[..., o3:o4], proj[..., o4:o5], proj[..., o5:]
    y_ssd = ssd_mixer(z, xbc, dt_raw, conv_w, conv_b, dt_bias, a_log, d_skip, norm_w)
    y_sc = sc_b * causal_dwconv(sc_c * sc_h, sc_conv_w)
    return jnp.concatenate([y_ssd.astype(x.dtype), y_sc.astype(x.dtype)], axis=-1) @ w_out


def sliding_window_attention(x, w_qkv, b_qkv, sinks, w_o, b_o):
    bsz, seqlen, _ = x.shape
    nb = seqlen // ATTN_BLOCK
    qkv = x @ w_qkv + b_qkv
    nq = ATTN_HEADS * ATTN_HEAD_DIM
    nkv = ATTN_KV_HEADS * ATTN_HEAD_DIM
    q = qkv[..., :nq].reshape(bsz, nb, ATTN_BLOCK, ATTN_KV_HEADS, ATTN_GROUP, ATTN_HEAD_DIM)
    k = qkv[..., nq:nq + nkv].reshape(bsz, nb, ATTN_BLOCK, ATTN_KV_HEADS, ATTN_HEAD_DIM)
    v = qkv[..., nq + nkv:].reshape(bsz, nb, ATTN_BLOCK, ATTN_KV_HEADS, ATTN_HEAD_DIM)

    def with_prev(t):
        prev = jnp.concatenate([jnp.zeros_like(t[:, :1]), t[:, :-1]], axis=1)
        return jnp.concatenate([prev, t], axis=2)

    kk = with_prev(k)
    vv = with_prev(v)
    scale = ATTN_HEAD_DIM ** -0.5
    s = jnp.einsum('bnqkgd,bnskd->bnkgqs', q, kk, preferred_element_type=jnp.float32) * scale
    n_idx = jnp.arange(nb)[:, None, None]
    q_pos = n_idx * ATTN_BLOCK + jnp.arange(ATTN_BLOCK)[None, :, None]
    k_pos = (n_idx - 1) * ATTN_BLOCK + jnp.arange(2 * ATTN_BLOCK)[None, None, :]
    rel = q_pos - k_pos
    band = (rel >= 0) & (rel < WINDOW) & (k_pos >= 0)
    s = jnp.where(band[None, :, None, None], s, -jnp.inf)
    sink = sinks.astype(jnp.float32).reshape(ATTN_KV_HEADS, ATTN_GROUP)[None, None, :, :, None, None]
    sink = jnp.broadcast_to(sink, s.shape[:-1] + (1,))
    probs = jax.nn.softmax(jnp.concatenate([s, sink], axis=-1), axis=-1)[..., :-1]
    o = jnp.einsum('bnkgqs,bnskd->bnqkgd', probs.astype(vv.dtype), vv)
    return o.reshape(bsz, seqlen, nq) @ w_o + b_o


def swiglu(x, w_gate, w_up, w_down):
    return (jax.nn.silu(x @ w_gate) * (x @ w_up)) @ w_down


def setup_inputs(seed: int = 0) -> dict:
    key = jax.random.key(seed)
    ks = jax.random.split(key, 32)
    f32 = jnp.float32

    def nrm(k, shape, scale):
        return jax.random.normal(k, shape, f32) * scale

    x = nrm(ks[0], (BATCH, SEQ, D_MODEL), 1.0)
    p = nrm(ks[1], (DEPTH, BATCH, SEQ, PLE_DIM), 1.0)
    w_in_mix = nrm(ks[2], (N_EVEN, D_MODEL, MIX_IN), D_MODEL ** -0.5)
    ssd_conv_w = nrm(ks[3], (N_EVEN, SSD_CONV, SSD_XBC), SSD_CONV ** -0.5)
    ssd_conv_b = nrm(ks[4], (N_EVEN, SSD_XBC), 0.02)
    dt0 = jnp.exp(jax.random.uniform(ks[5], (N_EVEN, SSD_HEADS), f32, math.log(1e-3), math.log(1e-1)))
    ssd_dt_bias = dt0 + jnp.log(-jnp.expm1(-dt0))
    ssd_a_log = jnp.log(jax.random.uniform(ks[6], (N_EVEN, SSD_HEADS), f32, 1.0, 16.0))
    ssd_d = 1.0 + nrm(ks[7], (N_EVEN, SSD_HEADS), 0.1)
    ssd_norm_w = 1.0 + nrm(ks[8], (N_EVEN, SSD_INNER), 0.02)
    sc_conv_w = nrm(ks[9], (N_EVEN, SC_CONV, SC_DIM), SC_CONV ** -0.5)
    w_out_mix = nrm(ks[10], (N_EVEN, MIX_OUT, D_MODEL), BETA * MIX_OUT ** -0.5)
    w_qkv = nrm(ks[11], (N_ODD, D_MODEL, QKV_DIM), D_MODEL ** -0.5)
    b_qkv = nrm(ks[12], (N_ODD, QKV_DIM), 0.02)
    attn_sinks = nrm(ks[13], (N_ODD, ATTN_HEADS), 0.5)
    w_o = nrm(ks[14], (N_ODD, ATTN_HEADS * ATTN_HEAD_DIM, D_MODEL), BETA * (ATTN_HEADS * ATTN_HEAD_DIM) ** -0.5)
    b_o = nrm(ks[15], (N_ODD, D_MODEL), 0.02)
    ln_mix_g = 1.0 + nrm(ks[16], (DEPTH, D_MODEL), 0.02)
    ln_mix_b = nrm(ks[17], (DEPTH, D_MODEL), 0.02)
    w_ffn_gate = nrm(ks[18], (DEPTH, D_MODEL, D_FF), D_MODEL ** -0.5)
    w_ffn_up = nrm(ks[19], (DEPTH, D_MODEL, D_FF), D_MODEL ** -0.5)
    w_ffn_down = nrm(ks[20], (DEPTH, D_FF, D_MODEL), BETA * D_FF ** -0.5)
    ln_ffn_g = 1.0 + nrm(ks[21], (DEPTH, D_MODEL), 0.02)
    ln_ffn_b = nrm(ks[22], (DEPTH, D_MODEL), 0.02)
    w_ple = nrm(ks[23], (DEPTH, PLE_DIM, D_MODEL), PLE_DIM ** -0.5)
    w_ple_gate = nrm(ks[24], (DEPTH, D_MODEL, D_MODEL), D_MODEL ** -0.5)
    b_ple_gate = nrm(ks[25], (DEPTH, D_MODEL), 0.02)
    return {'x': x, 'p': p, 'w_in_mix': w_in_mix, 'ssd_conv_w': ssd_conv_w, 'ssd_conv_b': ssd_conv_b,
            'ssd_dt_bias': ssd_dt_bias, 'ssd_a_log': ssd_a_log, 'ssd_d': ssd_d, 'ssd_norm_w': ssd_norm_w,
            'sc_conv_w': sc_conv_w, 'w_out_mix': w_out_mix, 'w_qkv': w_qkv, 'b_qkv': b_qkv,
            'attn_sinks': attn_sinks, 'w_o': w_o, 'b_o': b_o, 'ln_mix_g': ln_mix_g, 'ln_mix_b': ln_mix_b,
            'w_ffn_gate': w_ffn_gate, 'w_ffn_up': w_ffn_up, 'w_ffn_down': w_ffn_down,
            'ln_ffn_g': ln_ffn_g, 'ln_ffn_b': ln_ffn_b, 'w_ple': w_ple, 'w_ple_gate': w_ple_gate,
            'b_ple_gate': b_ple_gate}


def reference(x, p, w_in_mix, ssd_conv_w, ssd_conv_b, ssd_dt_bias, ssd_a_log, ssd_d, ssd_norm_w,
              sc_conv_w, w_out_mix, w_qkv, b_qkv, attn_sinks, w_o, b_o, ln_mix_g, ln_mix_b,
              w_ffn_gate, w_ffn_up, w_ffn_down, ln_ffn_g, ln_ffn_b, w_ple, w_ple_gate, b_ple_gate):
    for i in range(DEPTH):
        j = i // 2
        if i % 2 == 0:
            mix = ssd_shortconv_layer_mixer(x, w_in_mix[j], ssd_conv_w[j], ssd_conv_b[j], ssd_dt_bias[j],
                                            ssd_a_log[j], ssd_d[j], ssd_norm_w[j], sc_conv_w[j], w_out_mix[j])
        else:
            mix = sliding_window_attention(x, w_qkv[j], b_qkv[j], attn_sinks[j], w_o[j], b_o[j])
        x = layer_norm(ALPHA * x + mix.astype(x.dtype), ln_mix_g[i], ln_mix_b[i])
        x = layer_norm(ALPHA * x + swiglu(x, w_ffn_gate[i], w_ffn_up[i], w_ffn_down[i]), ln_ffn_g[i], ln_ffn_b[i])
        gate = jax.nn.sigmoid(x @ w_ple_gate[i] + b_ple_gate[i])
        x = x + (p[i] @ w_ple[i]) * gate
    return x
```

```cpp
#include <hip/hip_runtime.h>
#include <hip/hip_cooperative_groups.h>
#include <cstdio>
#include <cstdint>
namespace cg = cooperative_groups;

#define LAS __attribute__((address_space(3)))
#define DI __device__ __forceinline__
typedef unsigned short bf16_t;
typedef short bf16x8 __attribute__((ext_vector_type(8)));
typedef short s16x4 __attribute__((ext_vector_type(4)));
typedef float f32x4 __attribute__((ext_vector_type(4)));
typedef float f32x2 __attribute__((ext_vector_type(2)));
typedef float f32x16 __attribute__((ext_vector_type(16)));
typedef unsigned u32x4 __attribute__((ext_vector_type(4)));
typedef unsigned u32x2 __attribute__((ext_vector_type(2)));
typedef __bf16 bf16x2_t __attribute__((ext_vector_type(2)));

constexpr int NBATCH = 8, SEQ = 2048, DM = 1024, M = NBATCH * SEQ;
constexpr int PLE_DIM = 256, DFF = 2816;
constexpr int MIX_IN = 5648, XBC = 1536;
constexpr int LDP = 4608;
constexpr int P_Z = 0, P_SCB = 1024, P_XBC = 2048, P_PROD = 3584;
constexpr int N_IN = 5888;
constexpr int QKV = 1536;
constexpr float ALPHA = 1.4142135623730951f;
constexpr float LN_EPS = 1e-5f, RMS_EPS = 1e-5f;
constexpr int NTHR = 512;
constexpr int LDS_BYTES = 131072;

constexpr size_t WS_WIN = 0;
constexpr size_t WS_WOUT = WS_WIN + (size_t)N_IN * DM * 2;
constexpr size_t WS_WGU0 = WS_WOUT + (size_t)DM * 2048 * 2;
constexpr size_t SZ_WGU = (size_t)2 * DFF * DM * 2;
constexpr size_t WS_WDN0 = WS_WGU0 + 2 * SZ_WGU;
constexpr size_t SZ_WDN = (size_t)DM * DFF * 2;
constexpr size_t WS_WPG0 = WS_WDN0 + 2 * SZ_WDN;
constexpr size_t SZ_WPG = (size_t)DM * DM * 2;
constexpr size_t WS_WPL0 = WS_WPG0 + 2 * SZ_WPG;
constexpr size_t SZ_WPL = (size_t)DM * PLE_DIM * 2;
constexpr size_t WS_WQKV = WS_WPL0 + 2 * SZ_WPL;
constexpr size_t WS_WO = WS_WQKV + (size_t)QKV * DM * 2;
constexpr size_t WS_XB = WS_WO + (size_t)DM * DM * 2;
constexpr size_t WS_DTRAW = WS_XB + (size_t)M * DM * 2;
constexpr size_t WS_DTV = WS_DTRAW + (size_t)M * 16 * 4;
constexpr size_t WS_ACS = WS_DTV + (size_t)M * 16 * 4;
constexpr size_t WS_SS = WS_ACS + (size_t)M * 16 * 4;
constexpr size_t WS_CDEC = WS_SS + (size_t)M * 32 * 4;
constexpr size_t WS_PROJ = WS_CDEC + 65536;
constexpr size_t MiB = 1u << 20;
constexpr size_t WS_H = WS_PROJ;
constexpr size_t WS_U = WS_PROJ + 96 * MiB;
constexpr size_t WS_PB = WS_PROJ + 128 * MiB;
constexpr size_t WS_QKVB = WS_PROJ;
constexpr size_t WS_OB = WS_PROJ + 48 * MiB;
constexpr size_t WS_END = WS_PROJ + (size_t)M * LDP * 2;
static_assert(WS_END <= 268435456, "workspace map exceeds 256 MiB");
static_assert(WS_PB + (size_t)M * 256 * 2 <= WS_END, "pb fits");

DI unsigned pk2(float lo, float hi) { f32x2 v = {lo, hi}; bf16x2_t b = __builtin_convertvector(v, bf16x2_t); return __builtin_bit_cast(unsigned, b); }
DI float bflo(unsigned u) { return __uint_as_float(u << 16); }
DI float bfhi(unsigned u) { return __uint_as_float(u & 0xffff0000u); }
DI bf16_t f2bf(float f) { return (bf16_t)(pk2(f, 0.f) & 0xffffu); }
DI float silu_f(float x) { return x * __builtin_amdgcn_rcpf(1.f + __expf(-x)); }
DI float sigmoid_f(float x) { return __builtin_amdgcn_rcpf(1.f + __expf(-x)); }
DI int crow(int reg, int h) { return (reg & 3) + 8 * (reg >> 2) + 4 * h; }
#define MFMA32(a, b, c) __builtin_amdgcn_mfma_f32_32x32x16_bf16((a), (b), (c), 0, 0, 0)
DI f32x16 zero16() { f32x16 z; for (int i = 0; i < 16; ++i) z[i] = 0.f; return z; }
DI bf16x8 pack8(float a0, float a1, float a2, float a3, float a4, float a5, float a6, float a7) {
    u32x4 p; p.x = pk2(a0, a1); p.y = pk2(a2, a3); p.z = pk2(a4, a5); p.w = pk2(a6, a7); return __builtin_bit_cast(bf16x8, p);
}
DI bf16x8 cat4(s16x4 lo, s16x4 hi) { bf16x8 r; r[0] = lo[0]; r[1] = lo[1]; r[2] = lo[2]; r[3] = lo[3]; r[4] = hi[0]; r[5] = hi[1]; r[6] = hi[2]; r[7] = hi[3]; return r; }

namespace pg8 {
constexpr int BM = 256, BK = 64, HALF = 128, HTB = HALF * BK * 2, STAGE_BYTES = 8 * HTB, NXCD = 8, WGM = 8;
__host__ __device__ __forceinline__ int lds_byte(int r, int c) { const int st = (r >> 4) * 2 + (c >> 5), rr = r & 15, cc = c & 31, ob = rr * 64 + cc * 2; return st * 1024 + (ob ^ (((ob >> 9) & 1) << 5)); }
__host__ __device__ __forceinline__ void stage_rc(int b, int& R, int& C) { const int st = b / 1024, sb = b % 1024, swz = sb ^ (((sb >> 9) & 1) << 5); R = (st >> 1) * 16 + swz / 64; C = (st & 1) * 32 + (swz % 64) / 2; }
__host__ __device__ __forceinline__ int perm32(int rho) { const int n = rho >> 4, i = rho & 15; return 8 * (i >> 2) + 4 * n + (i & 3); }

struct Unit { int pm, pn; };
struct Gemm { const bf16_t* A; const bf16_t* Bt; int M, N, K, lda; };

struct StaticOrder {
    int nM, nN, nwg, G, c;
    __host__ __device__ void init(int M_, int N_, int G_, int c_) { nM = M_ / BM; nN = N_ / BM; nwg = nM * nN; G = G_; c = c_; }
    __host__ __device__ bool next(int i, Unit& u) const {
        const long L = (long)i * G + c; if (L >= nwg) return false;
        int wgid = (int)L; { const int q = nwg / NXCD, r = nwg % NXCD, xcd = wgid % NXCD, off = wgid / NXCD; wgid = (xcd < r ? xcd * (q + 1) : r * (q + 1) + (xcd - r) * q) + off; }
        const int nig = WGM * nN, gid = wgid / nig, fm = gid * WGM, gsz = (nM - fm) < WGM ? (nM - fm) : WGM;
        u.pm = fm + ((wgid % nig) % gsz); u.pn = (wgid % nig) / gsz; return true;
    }
};

template <class Epi>
__device__ __forceinline__ void gemm_phase(LAS unsigned char* lds, const Gemm g, const StaticOrder& S, const Epi& E) {
    int tid_ = threadIdx.x; asm volatile("" : "+v"(tid_));
    const int tid = tid_, wid = __builtin_amdgcn_readfirstlane(tid >> 6), lane = tid & 63, wr = wid >> 2, wc = wid & 3, fr = lane & 15, fq = lane >> 4;
    const int K = g.K, nt = K / BK, lda = g.lda;
    unsigned voffA[2], voffB[2];
#pragma unroll
    for (int i = 0; i < 2; ++i) { int R, C; stage_rc(tid * 16 + i * 8192, R, C); const int Rb = (R & ~31) + perm32(R & 31);
        voffA[i] = (unsigned)(R * lda + C) * 2u; voffB[i] = (unsigned)(Rb * K + C) * 2u; }
    const size_t kstep = (size_t)(BK * 2);
    const size_t hstepA = (size_t)HALF * lda * 2, hstepB = (size_t)HALF * K * 2;
    const size_t tstepA = 2 * hstepA, tstepB = 2 * hstepB;
    const unsigned ldsw = (unsigned)wid * 1024u;
    const int aoff = lds_byte(wr * 64 + fr, fq * 8), boff = lds_byte(wc * 32 + fr, fq * 8);
#define PG8_SA(b, h) (((b) * 2 + (h)) * HTB)
#define PG8_SB(b, h) ((4 + (b) * 2 + (h)) * HTB)
#define PG8_STAGE(bufoff, gbase, voff) do { _Pragma("unroll") for (int _i = 0; _i < 2; ++_i) \
        __builtin_amdgcn_global_load_lds((const unsigned*)((const char*)(gbase) + (voff)[_i]), (LAS unsigned*)(lds + (bufoff) + ldsw + _i * 8192), 16, 0, 0); } while (0)
#define PG8_LDA(dst, b, h) do { _Pragma("unroll") for (int m = 0; m < 4; ++m) _Pragma("unroll") for (int k = 0; k < 2; ++k) dst[m][k] = *(const LAS bf16x8*)(lds + PG8_SA(b, h) + aoff + m * 2048 + k * 1024); } while (0)
#define PG8_LDB(dst, b, h) do { _Pragma("unroll") for (int n = 0; n < 2; ++n) _Pragma("unroll") for (int k = 0; k < 2; ++k) dst[n][k] = *(const LAS bf16x8*)(lds + PG8_SB(b, h) + boff + n * 2048 + k * 1024); } while (0)
#define PG8_MMA(ai, bj, At, Bt) do { __builtin_amdgcn_s_setprio(1); _Pragma("unroll") for (int m = 0; m < 4; ++m) _Pragma("unroll") for (int n = 0; n < 2; ++n) _Pragma("unroll") for (int k = 0; k < 2; ++k) \
        acc[ai][bj][m][n] = __builtin_amdgcn_mfma_f32_16x16x32_bf16(Bt[n][k], At[m][k], acc[ai][bj][m][n], 0, 0, 0); __builtin_amdgcn_s_setprio(0); } while (0)
#define PG8_WAIT_V(n) asm volatile("s_waitcnt vmcnt(" #n ")" ::: "memory")
#define PG8_WAIT_L(n) asm volatile("s_waitcnt lgkmcnt(" #n ")" ::: "memory")
#define PG8_BAR __builtin_amdgcn_s_barrier()
#define PG8_SCHED __builtin_amdgcn_sched_barrier(0)
    Unit cur, nxt; int ui = 0;
    if (!S.next(0, cur)) return;
    f32x4 acc[2][2][4][2];
#pragma unroll
    for (int a = 0; a < 2; ++a)
#pragma unroll
        for (int b = 0; b < 2; ++b)
#pragma unroll
            for (int m = 0; m < 4; ++m)
#pragma unroll
                for (int n = 0; n < 2; ++n) acc[a][b][m][n] = (f32x4){0.f, 0.f, 0.f, 0.f};
    bf16x8 At[4][2], B0[2][2], B1[2][2];
    const char* cA = (const char*)g.A + (size_t)cur.pm * tstepA; const char* cB = (const char*)g.Bt + (size_t)cur.pn * tstepB;
    {
        PG8_STAGE(PG8_SB(0, 0), cB, voffB); PG8_STAGE(PG8_SB(0, 1), cB + hstepB, voffB); PG8_STAGE(PG8_SA(0, 0), cA, voffA); PG8_STAGE(PG8_SA(0, 1), cA + hstepA, voffA);
        if (wr == 1) PG8_BAR;
        PG8_WAIT_V(2); PG8_BAR;
        PG8_STAGE(PG8_SB(1, 0), cB + kstep, voffB); PG8_STAGE(PG8_SA(1, 0), cA + kstep, voffA); PG8_STAGE(PG8_SB(1, 1), cB + hstepB + kstep, voffB);
        PG8_WAIT_V(6); PG8_BAR;
    }
    for (;;) {
        const bool has_next = S.next(ui + 1, nxt);
        const char* nA = has_next ? (const char*)g.A + (size_t)nxt.pm * tstepA : cA; const char* nB = has_next ? (const char*)g.Bt + (size_t)nxt.pn * tstepB : cB;
#pragma unroll 1
        for (int t = 0; t < nt; t += 2) {
            const bool last = (t == nt - 2);
            const char* a1 = cA + (size_t)(t + 1) * kstep;
            const char* a2 = last ? nA : cA + (size_t)(t + 2) * kstep; const char* b2 = last ? nB : cB + (size_t)(t + 2) * kstep;
            const char* a3 = a2 + kstep; const char* b3 = b2 + kstep;
            PG8_LDB(B0, 0, 0); PG8_LDB(B1, 0, 1); PG8_SCHED; PG8_LDA(At, 0, 0); PG8_STAGE(PG8_SA(1, 1), a1 + hstepA, voffA);
            PG8_WAIT_V(8); PG8_WAIT_L(0); PG8_BAR; PG8_MMA(0, 0, At, B0); PG8_MMA(0, 1, At, B1); PG8_BAR; PG8_SCHED;
            PG8_LDA(At, 0, 1); PG8_STAGE(PG8_SB(0, 0), b2, voffB); PG8_STAGE(PG8_SB(0, 1), b2 + hstepB, voffB); PG8_STAGE(PG8_SA(0, 0), a2, voffA);
            PG8_WAIT_V(8); PG8_WAIT_L(0); PG8_BAR; PG8_MMA(1, 0, At, B0); PG8_MMA(1, 1, At, B1); PG8_BAR; PG8_SCHED;
            PG8_LDB(B0, 1, 0); PG8_LDB(B1, 1, 1); PG8_SCHED; PG8_LDA(At, 1, 0); PG8_STAGE(PG8_SA(0, 1), a2 + hstepA, voffA);
            PG8_WAIT_V(8); PG8_WAIT_L(0); PG8_BAR; PG8_MMA(0, 0, At, B0); PG8_MMA(0, 1, At, B1); PG8_BAR; PG8_SCHED;
            PG8_LDA(At, 1, 1); PG8_STAGE(PG8_SB(1, 0), b3, voffB); PG8_STAGE(PG8_SB(1, 1), b3 + hstepB, voffB); PG8_STAGE(PG8_SA(1, 0), a3, voffA);
            PG8_WAIT_V(8); PG8_WAIT_L(0); PG8_BAR; PG8_MMA(1, 0, At, B0); PG8_MMA(1, 1, At, B1); PG8_BAR; PG8_SCHED;
        }
        if (wr == 0) PG8_BAR;
        E(acc, cur, wr, wc, fr, fq);
        if (!has_next) break;
#pragma unroll
        for (int a = 0; a < 2; ++a)
#pragma unroll
            for (int b = 0; b < 2; ++b)
#pragma unroll
                for (int m = 0; m < 4; ++m)
#pragma unroll
                    for (int n = 0; n < 2; ++n) acc[a][b][m][n] = (f32x4){0.f, 0.f, 0.f, 0.f};
        cur = nxt; cA = nA; cB = nB; ++ui;
        if (wr == 1) PG8_BAR;
    }
    PG8_WAIT_V(0);
    PG8_BAR;
#undef PG8_SA
#undef PG8_SB
#undef PG8_STAGE
#undef PG8_LDA
#undef PG8_LDB
#undef PG8_MMA
#undef PG8_WAIT_V
#undef PG8_WAIT_L
#undef PG8_BAR
#undef PG8_SCHED
}
}
using pg8::Unit;
typedef f32x4 AccT[2][2][4][2];

DI void store8bf(bf16_t* p, f32x4 v0, f32x4 v1) { u32x4 w; w.x = pk2(v0[0], v0[1]); w.y = pk2(v0[2], v0[3]); w.z = pk2(v1[0], v1[1]); w.w = pk2(v1[2], v1[3]); *(u32x4*)p = w; }

struct EpiIn {
    bf16_t* proj; float* dtraw;
    DI void operator()(const AccT& acc, const Unit& u, int wr, int wc, int fr, int fq) const {
        const int row0 = u.pm * 256 + wr * 64 + fr;
        if (u.pn < 14) {
            const int col0 = u.pn * 256 + wc * 32 + 8 * fq;
#pragma unroll
            for (int ai = 0; ai < 2; ++ai)
#pragma unroll
                for (int m = 0; m < 4; ++m) { bf16_t* rp = proj + (size_t)(row0 + ai * 128 + m * 16) * LDP + col0;
#pragma unroll
                    for (int bj = 0; bj < 2; ++bj) store8bf(rp + bj * 128, acc[ai][bj][m][0], acc[ai][bj][m][1]); }
        } else if (u.pn < 22) {
            const int col0 = P_PROD + (u.pn - 14) * 128 + wc * 32 + 8 * fq;
#pragma unroll
            for (int ai = 0; ai < 2; ++ai)
#pragma unroll
                for (int m = 0; m < 4; ++m) { bf16_t* rp = proj + (size_t)(row0 + ai * 128 + m * 16) * LDP + col0;
                    store8bf(rp, acc[ai][0][m][0] * acc[ai][1][m][0], acc[ai][0][m][1] * acc[ai][1][m][1]); }
        } else {
            if (wc == 0 && fq < 2) {
#pragma unroll
                for (int ai = 0; ai < 2; ++ai)
#pragma unroll
                    for (int m = 0; m < 4; ++m) { float* rp = dtraw + (size_t)(row0 + ai * 128 + m * 16) * 16 + 8 * fq;
                        *(f32x4*)rp = acc[ai][0][m][0]; *(f32x4*)(rp + 4) = acc[ai][0][m][1]; }
            }
        }
    }
};
struct EpiGlu {
    bf16_t* h;
    DI void operator()(const AccT& acc, const Unit& u, int wr, int wc, int fr, int fq) const {
        const int row0 = u.pm * 256 + wr * 64 + fr, col0 = u.pn * 128 + wc * 32 + 8 * fq;
#pragma unroll
        for (int ai = 0; ai < 2; ++ai)
#pragma unroll
            for (int m = 0; m < 4; ++m) { bf16_t* rp = h + (size_t)(row0 + ai * 128 + m * 16) * DFF + col0;
                f32x4 v0, v1;
#pragma unroll
                for (int i = 0; i < 4; ++i) { v0[i] = silu_f(acc[ai][0][m][0][i]) * acc[ai][1][m][0][i]; v1[i] = silu_f(acc[ai][0][m][1][i]) * acc[ai][1][m][1][i]; }
                store8bf(rp, v0, v1); __builtin_amdgcn_sched_barrier(0); }
    }
};
struct EpiRes {
    const float* res; float* out; const float* bias;
    DI void operator()(const AccT& acc, const Unit& u, int wr, int wc, int fr, int fq) const {
        const int row0 = u.pm * 256 + wr * 64 + fr, col0 = u.pn * 256 + wc * 32 + 8 * fq;
#pragma unroll
        for (int bj = 0; bj < 2; ++bj) {
            f32x4 b0 = {0.f, 0.f, 0.f, 0.f}, b1 = {0.f, 0.f, 0.f, 0.f};
            if (bias) { b0 = *(const f32x4*)(bias + col0 + bj * 128); b1 = *(const f32x4*)(bias + col0 + bj * 128 + 4); }
#pragma unroll
            for (int ai = 0; ai < 2; ++ai)
#pragma unroll
                for (int m = 0; m < 4; ++m) { const size_t o = (size_t)(row0 + ai * 128 + m * 16) * DM + col0 + bj * 128;
                    const f32x4 r0 = *(const f32x4*)(res + o), r1 = *(const f32x4*)(res + o + 4);
                    *(f32x4*)(out + o) = r0 * ALPHA + acc[ai][bj][m][0] + b0; *(f32x4*)(out + o + 4) = r1 * ALPHA + acc[ai][bj][m][1] + b1; if (m & 1) __builtin_amdgcn_sched_barrier(0); }
        }
    }
};
struct EpiBf {
    bf16_t* out; int ldc; const float* bias;
    DI void operator()(const AccT& acc, const Unit& u, int wr, int wc, int fr, int fq) const {
        const int row0 = u.pm * 256 + wr * 64 + fr, col0 = u.pn * 256 + wc * 32 + 8 * fq;
#pragma unroll
        for (int bj = 0; bj < 2; ++bj) {
            f32x4 b0 = {0.f, 0.f, 0.f, 0.f}, b1 = {0.f, 0.f, 0.f, 0.f};
            if (bias) { b0 = *(const f32x4*)(bias + col0 + bj * 128); b1 = *(const f32x4*)(bias + col0 + bj * 128 + 4); }
#pragma unroll
            for (int ai = 0; ai < 2; ++ai)
#pragma unroll
                for (int m = 0; m < 4; ++m)
                    store8bf(out + (size_t)(row0 + ai * 128 + m * 16) * ldc + col0 + bj * 128, acc[ai][bj][m][0] + b0, acc[ai][bj][m][1] + b1);
        }
    }
};
struct EpiPle {
    float* X; const bf16_t* U; const float* bias; bf16_t* xb;
    DI void operator()(const AccT& acc, const Unit& u, int wr, int wc, int fr, int fq) const {
        const int row0 = u.pm * 256 + wr * 64 + fr, col0 = u.pn * 256 + wc * 32 + 8 * fq;
#pragma unroll
        for (int bj = 0; bj < 2; ++bj) {
            const f32x4 b0 = *(const f32x4*)(bias + col0 + bj * 128), b1 = *(const f32x4*)(bias + col0 + bj * 128 + 4);
#pragma unroll
            for (int ai = 0; ai < 2; ++ai)
#pragma unroll
                for (int m = 0; m < 4; ++m) { const size_t o = (size_t)(row0 + ai * 128 + m * 16) * DM + col0 + bj * 128;
                    const u32x4 ur = *(const u32x4*)(U + o);
                    const f32x4 x0 = *(const f32x4*)(X + o), x1 = *(const f32x4*)(X + o + 4);
                    const f32x4 a0 = acc[ai][bj][m][0] + b0, a1 = acc[ai][bj][m][1] + b1;
                    f32x4 y0, y1;
                    y0[0] = x0[0] + bflo(ur.x) * sigmoid_f(a0[0]); y0[1] = x0[1] + bfhi(ur.x) * sigmoid_f(a0[1]);
                    y0[2] = x0[2] + bflo(ur.y) * sigmoid_f(a0[2]); y0[3] = x0[3] + bfhi(ur.y) * sigmoid_f(a0[3]);
                    y1[0] = x1[0] + bflo(ur.z) * sigmoid_f(a1[0]); y1[1] = x1[1] + bfhi(ur.z) * sigmoid_f(a1[1]);
                    y1[2] = x1[2] + bflo(ur.w) * sigmoid_f(a1[2]); y1[3] = x1[3] + bfhi(ur.w) * sigmoid_f(a1[3]);
                    *(f32x4*)(X + o) = y0; *(f32x4*)(X + o + 4) = y1;
                    store8bf(xb + o, y0, y1); __builtin_amdgcn_sched_barrier(0); }
        }
    }
};

struct Params {
    const float* in[26];
    float* out;
    unsigned char* ws;
    int ph_lo, ph_hi;
};
enum { I_X = 0, I_P, I_WIN, I_CONVW, I_CONVB, I_DTB, I_ALOG, I_DSKIP, I_NORMW, I_SCW, I_WOUT, I_WQKV, I_BQKV, I_SINK, I_WO, I_BO,
       I_LNMG, I_LNMB, I_WG, I_WU, I_WD, I_LNFG, I_LNFB, I_WPLE, I_WPG, I_BPG };

DI void tr_item(const float* W, int ldw, int k0, int src_col, int nvalid, bf16_t* WT, int K, int dst_row, LAS float* scr, int lane) {
    const int c = lane & 31;
#pragma unroll 8
    for (int i = 0; i < 32; ++i) { const int kk = 2 * i + (lane >> 5); scr[kk * 33 + c] = (c < nvalid) ? W[(size_t)(k0 + kk) * ldw + src_col + c] : 0.f; }
    asm volatile("s_waitcnt lgkmcnt(0)" ::: "memory");
    const int c8 = lane & 7;
#pragma unroll
    for (int j = 0; j < 4; ++j) { const int n = (lane >> 3) + 8 * j; const LAS float* s = scr + (8 * c8) * 33 + n;
        u32x4 o; o.x = pk2(s[0 * 33], s[1 * 33]); o.y = pk2(s[2 * 33], s[3 * 33]); o.z = pk2(s[4 * 33], s[5 * 33]); o.w = pk2(s[6 * 33], s[7 * 33]);
        *(u32x4*)(WT + (size_t)(dst_row + n) * K + k0 + 8 * c8) = o; }
    asm volatile("s_waitcnt lgkmcnt(0)" ::: "memory");
}

DI void cvt_rows_bf16(const float* src, bf16_t* dst, size_t n8, int gtid, int nthreads) {
    for (size_t i = gtid; i < n8; i += nthreads) {
        const f32x4 a = *(const f32x4*)(src + i * 8), b = *(const f32x4*)(src + i * 8 + 4);
        store8bf(dst + i * 8, a, b);
    }
}

DI void prologue_phase(const Params& p, LAS unsigned char* lds) {
    int tid_ = threadIdx.x; asm volatile("" : "+v"(tid_));
    const int tid = tid_, lane = tid & 63, wid = tid >> 6;
    LAS float* scr = (LAS float*)(lds + wid * 16384);
    const int gw = blockIdx.x * 8 + wid, NGW = gridDim.x * 8;
    unsigned char* ws = p.ws;
    constexpr int IT_IN = 16 * (N_IN / 32), IT_OUT = 32 * 32, IT_GU = 16 * (2 * DFF / 32), IT_DN = (DFF / 64) * 32, IT_PG = 16 * 32, IT_PL = 4 * 32, IT_QKV = 16 * (QKV / 32), IT_O = 16 * 32;
    constexpr int NITEMS = IT_IN + IT_OUT + 2 * (IT_GU + IT_DN + IT_PG + IT_PL) + IT_QKV + IT_O;
    for (int it = gw; it < NITEMS; it += NGW) {
        int r = it;
        if (r < IT_IN) {
            const int nblk = r % (N_IN / 32), kb = r / (N_IN / 32), d = nblk * 32; int src = 0, nv = 32;
            if (d < 1024) src = d; else if (d < 2048) src = 2576 + (d - 1024); else if (d < 3584) src = 1024 + (d - 2048);
            else if (d < 5632) { const int q = d - 3584, tile = q / 256, w = q % 256; src = (w < 128 ? 3600 : 4624) + 128 * tile + (w % 128); }
            else if (d == 5632) { src = 2560; nv = 16; } else { src = 0; nv = 0; }
            tr_item(p.in[I_WIN], MIX_IN, kb * 64, src, nv, (bf16_t*)(ws + WS_WIN), DM, d, scr, lane); continue; }
        r -= IT_IN;
        if (r < IT_OUT) { const int nblk = r % 32, kb = r / 32; tr_item(p.in[I_WOUT], DM, kb * 64, nblk * 32, 32, (bf16_t*)(ws + WS_WOUT), 2048, nblk * 32, scr, lane); continue; }
        r -= IT_OUT;
        bool done = false;
#pragma unroll
        for (int l = 0; l < 2; ++l) {
            if (done) break;
            if (r < IT_GU) { const int nblk = r % (2 * DFF / 32), kb = r / (2 * DFF / 32), d = nblk * 32, tile = d / 256, w = d % 256;
                const float* W = (w < 128 ? p.in[I_WG] : p.in[I_WU]) + (size_t)l * DM * DFF;
                tr_item(W, DFF, kb * 64, 128 * tile + (w % 128), 32, (bf16_t*)(ws + WS_WGU0 + l * SZ_WGU), DM, d, scr, lane); done = true; break; }
            r -= IT_GU;
            if (r < IT_DN) { const int nblk = r % 32, kb = r / 32; tr_item(p.in[I_WD] + (size_t)l * DFF * DM, DM, kb * 64, nblk * 32, 32, (bf16_t*)(ws + WS_WDN0 + l * SZ_WDN), DFF, nblk * 32, scr, lane); done = true; break; }
            r -= IT_DN;
            if (r < IT_PG) { const int nblk = r % 32, kb = r / 32; tr_item(p.in[I_WPG] + (size_t)l * DM * DM, DM, kb * 64, nblk * 32, 32, (bf16_t*)(ws + WS_WPG0 + l * SZ_WPG), DM, nblk * 32, scr, lane); done = true; break; }
            r -= IT_PG;
            if (r < IT_PL) { const int nblk = r % 32, kb = r / 32; tr_item(p.in[I_WPLE] + (size_t)l * PLE_DIM * DM, DM, kb * 64, nblk * 32, 32, (bf16_t*)(ws + WS_WPL0 + l * SZ_WPL), PLE_DIM, nblk * 32, scr, lane); done = true; break; }
            r -= IT_PL;
        }
        if (done) continue;
        if (r < IT_QKV) { const int nblk = r % (QKV / 32), kb = r / (QKV / 32); tr_item(p.in[I_WQKV], QKV, kb * 64, nblk * 32, 32, (bf16_t*)(ws + WS_WQKV), DM, nblk * 32, scr, lane); continue; }
        r -= IT_QKV;
        { const int nblk = r % 32, kb = r / 32; tr_item(p.in[I_WO], DM, kb * 64, nblk * 32, 32, (bf16_t*)(ws + WS_WO), DM, nblk * 32, scr, lane); }
    }
    cvt_rows_bf16(p.in[I_X], (bf16_t*)(ws + WS_XB), (size_t)M * DM / 8, blockIdx.x * NTHR + tid, gridDim.x * NTHR);
}

DI void conv8(const bf16_t* projb, int t, int ch, const float* cw, const float* cb, float (&o)[8]) {
    const f32x4 b0 = *(const f32x4*)(cb + ch), b1 = *(const f32x4*)(cb + ch + 4);
    float a[8] = {b0[0], b0[1], b0[2], b0[3], b1[0], b1[1], b1[2], b1[3]};
#pragma unroll
    for (int k = 0; k < 4; ++k) {
        const int tt = t - 3 + k;
        if (tt >= 0) {
            const u32x4 raw = *(const u32x4*)(projb + (size_t)tt * LDP + P_XBC + ch);
            const f32x4 w0 = *(const f32x4*)(cw + k * XBC + ch), w1 = *(const f32x4*)(cw + k * XBC + ch + 4);
            a[0] += w0[0] * bflo(raw.x); a[1] += w0[1] * bfhi(raw.x); a[2] += w0[2] * bflo(raw.y); a[3] += w0[3] * bfhi(raw.y);
            a[4] += w1[0] * bflo(raw.z); a[5] += w1[1] * bfhi(raw.z); a[6] += w1[2] * bflo(raw.w); a[7] += w1[3] * bfhi(raw.w);
        }
    }
#pragma unroll
    for (int j = 0; j < 8; ++j) o[j] = silu_f(a[j]);
}

constexpr int PT = 136;

DI void ssd_s1_phase(const Params& p, LAS unsigned char* lds) {
    int tid_ = threadIdx.x; asm volatile("" : "+v"(tid_));
    const int tid = tid_, lane = tid & 63, wid = tid >> 6, l32 = lane & 31, hh = lane >> 5;
    LAS bf16_t* BT = (LAS bf16_t*)lds;
    LAS bf16_t* XW = (LAS bf16_t*)(lds + 34816);
    LAS float* ACS = (LAS float*)(lds + 34816 + 2 * 17408);
    LAS float* DTS = ACS + 1024;
    const bf16_t* proj = (const bf16_t*)(p.ws + WS_PROJ);
    const float* dtraw = (const float*)(p.ws + WS_DTRAW);
    float* dtv = (float*)(p.ws + WS_DTV); float* acsg = (float*)(p.ws + WS_ACS); float* cdec = (float*)(p.ws + WS_CDEC);
    bf16_t* states = (bf16_t*)(p.ws + WS_XB);
    const float* cw = p.in[I_CONVW]; const float* cb = p.in[I_CONVB];
    for (int unit = blockIdx.x; unit < 256; unit += gridDim.x) {
        const int b = unit >> 5, c = (unit >> 1) & 15, g = unit & 1;
        const int t0 = c * 128, row0 = b * SEQ + t0;
        const bf16_t* projb = proj + (size_t)b * SEQ * LDP;
        {
            const int h = 8 * g + wid; const float bias = p.in[I_DTB][h], A = -expf(p.in[I_ALOG][h]);
            const int l0 = 2 * lane;
            const float x0 = dtraw[(size_t)(row0 + l0) * 16 + h] + bias, x1 = dtraw[(size_t)(row0 + l0 + 1) * 16 + h] + bias;
            const float d0 = x0 > 20.f ? x0 : log1pf(expf(x0)), d1 = x1 > 20.f ? x1 : log1pf(expf(x1));
            const float a0 = d0 * A, a1 = d1 * A, s = a0 + a1;
            float incl = s;
#pragma unroll
            for (int o = 1; o < 64; o <<= 1) { const float tv = __shfl_up(incl, o); if (lane >= o) incl += tv; }
            const float c0 = incl - s + a0, c1 = incl;
            ACS[wid * 128 + l0] = c0; ACS[wid * 128 + l0 + 1] = c1; DTS[wid * 128 + l0] = d0; DTS[wid * 128 + l0 + 1] = d1;
            acsg[(size_t)(row0 + l0) * 16 + h] = c0; acsg[(size_t)(row0 + l0 + 1) * 16 + h] = c1;
            dtv[(size_t)(row0 + l0) * 16 + h] = d0; dtv[(size_t)(row0 + l0 + 1) * 16 + h] = d1;
            if (lane == 63) cdec[(b * 16 + c) * 16 + h] = expf(c1);
        }
        for (int task = tid; task < 128 * 16; task += NTHR) {
            const int l = task & 127, cg8 = task >> 7; float v[8];
            conv8(projb, t0 + l, 1024 + 128 * g + 8 * cg8, cw, cb, v);
#pragma unroll
            for (int j = 0; j < 8; ++j) BT[(8 * cg8 + j) * PT + l] = f2bf(v[j]);
        }
        __syncthreads();
        for (int r = 0; r < 8; ++r) {
            const int h = 8 * g + r;
            LAS bf16_t* buf = XW + (r & 1) * 64 * PT;
            const float alast = ACS[r * 128 + 127];
            for (int task = tid; task < 128 * 8; task += NTHR) {
                const int l = task & 127, cg8 = task >> 7; float v[8];
                conv8(projb, t0 + l, 64 * h + 8 * cg8, cw, cb, v);
                const float sc = DTS[r * 128 + l] * __expf(alast - ACS[r * 128 + l]);
#pragma unroll
                for (int j = 0; j < 8; ++j) buf[(8 * cg8 + j) * PT + l] = f2bf(v[j] * sc);
            }
            __syncthreads();
            const int pb = wid >> 2, nb = wid & 3;
            f32x16 acc = zero16();
#pragma unroll
            for (int t = 0; t < 8; ++t) {
                const bf16x8 a = *(const LAS bf16x8*)(buf + (pb * 32 + l32) * PT + 16 * t + 8 * hh);
                const bf16x8 bb = *(const LAS bf16x8*)(BT + (nb * 32 + l32) * PT + 16 * t + 8 * hh);
                acc = MFMA32(a, bb, acc);
            }
            bf16_t* sp = states + ((size_t)((b * 16 + c) * 16 + h) * 64) * 128;
#pragma unroll
            for (int i = 0; i < 16; ++i) sp[(size_t)(pb * 32 + crow(i, hh)) * 128 + nb * 32 + l32] = f2bf(acc[i]);
        }
        __syncthreads();
    }
}

DI void ssd_scan_phase(const Params& p) {
    bf16_t* states = (bf16_t*)(p.ws + WS_XB); const float* cdec = (const float*)(p.ws + WS_CDEC);
    const int total = NBATCH * 16 * 64 * 16;
    for (int idx = blockIdx.x * NTHR + threadIdx.x; idx < total; idx += gridDim.x * NTHR) {
        const int n8 = idx & 15, pp = (idx >> 4) & 63, h = (idx >> 10) & 15, b = idx >> 14;
        float st[8] = {0.f, 0.f, 0.f, 0.f, 0.f, 0.f, 0.f, 0.f};
        for (int c = 0; c < 16; ++c) {
            bf16_t* ptr = states + ((size_t)(((b * 16 + c) * 16 + h) * 64 + pp)) * 128 + n8 * 8;
            const u32x4 raw = *(const u32x4*)ptr; const float dec = cdec[(b * 16 + c) * 16 + h];
            u32x4 o; o.x = pk2(st[0], st[1]); o.y = pk2(st[2], st[3]); o.z = pk2(st[4], st[5]); o.w = pk2(st[6], st[7]);
            *(u32x4*)ptr = o;
            st[0] = st[0] * dec + bflo(raw.x); st[1] = st[1] * dec + bfhi(raw.x); st[2] = st[2] * dec + bflo(raw.y); st[3] = st[3] * dec + bfhi(raw.y);
            st[4] = st[4] * dec + bflo(raw.z); st[5] = st[5] * dec + bfhi(raw.z); st[6] = st[6] * dec + bflo(raw.w); st[7] = st[7] * dec + bfhi(raw.w);
        }
    }
}

DI void ssd_s3_phase(const Params& p, LAS unsigned char* lds) {
    int tid_ = threadIdx.x; asm volatile("" : "+v"(tid_));
    const int tid = tid_, lane = tid & 63, wid = tid >> 6, l32 = lane & 31, hh = lane >> 5;
    LAS bf16_t* CS = (LAS bf16_t*)lds;
    LAS bf16_t* BS = (LAS bf16_t*)(lds + 34816);
    LAS bf16_t* XT = (LAS bf16_t*)(lds + 69632);
    LAS bf16_t* HS = (LAS bf16_t*)(lds + 87040);
    LAS float* ACS = (LAS float*)(lds + 104448);
    LAS float* DTS = ACS + 1024;
    bf16_t* proj = (bf16_t*)(p.ws + WS_PROJ);
    const float* dtv = (const float*)(p.ws + WS_DTV); const float* acsg = (const float*)(p.ws + WS_ACS);
    const bf16_t* states = (const bf16_t*)(p.ws + WS_XB);
    float* ssb = (float*)(p.ws + WS_SS);
    const float* cw = p.in[I_CONVW]; const float* cb = p.in[I_CONVB];
    for (int unit = blockIdx.x; unit < 256; unit += gridDim.x) {
        const int b = unit >> 5, c = (unit >> 1) & 15, g = unit & 1;
        const int t0 = c * 128, row0 = b * SEQ + t0;
        const bf16_t* projb = proj + (size_t)b * SEQ * LDP;
        __syncthreads();
        for (int i = tid; i < 1024; i += NTHR) { const int l = i >> 3, r = i & 7;
            ACS[r * 128 + l] = acsg[(size_t)(row0 + l) * 16 + 8 * g + r]; DTS[r * 128 + l] = dtv[(size_t)(row0 + l) * 16 + 8 * g + r]; }
        for (int task = tid; task < 128 * 32; task += NTHR) {
            const int cg = task & 31, l = task >> 5; float v[8];
            const int ch = (cg < 16) ? (1024 + 128 * g + 8 * cg) : (1280 + 128 * g + 8 * (cg - 16));
            conv8(projb, t0 + l, ch, cw, cb, v);
            u32x4 o; o.x = pk2(v[0], v[1]); o.y = pk2(v[2], v[3]); o.z = pk2(v[4], v[5]); o.w = pk2(v[6], v[7]);
            LAS bf16_t* dst = (cg < 16) ? (BS + l * PT + 8 * cg) : (CS + l * PT + 8 * (cg - 16));
            *(LAS u32x4*)dst = o;
        }
        __syncthreads();
        const int pb = wid >> 2, lb = wid & 3;
        f32x16 cbt[4];
#pragma unroll
        for (int sb = 0; sb < 4; ++sb) {
            cbt[sb] = zero16();
            if (sb <= lb) {
#pragma unroll
                for (int t = 0; t < 8; ++t) {
                    const bf16x8 a = *(const LAS bf16x8*)(BS + (sb * 32 + l32) * PT + 16 * t + 8 * hh);
                    const bf16x8 bb = *(const LAS bf16x8*)(CS + (lb * 32 + l32) * PT + 16 * t + 8 * hh);
                    cbt[sb] = MFMA32(a, bb, cbt[sb]);
                }
            }
        }
        for (int r = 0; r < 8; ++r) {
            const int h = 8 * g + r;
            __syncthreads();
            for (int task = tid; task < 128 * 8; task += NTHR) {
                const int l = task & 127, cg8 = task >> 7; float v[8];
                conv8(projb, t0 + l, 64 * h + 8 * cg8, cw, cb, v);
#pragma unroll
                for (int j = 0; j < 8; ++j) XT[(8 * cg8 + j) * PT + l] = f2bf(v[j]);
            }
            {
                const bf16_t* sp = states + ((size_t)((b * 16 + c) * 16 + h) * 64) * 128;
                for (int ck = tid; ck < 1024; ck += NTHR) { const int pp = ck >> 4, n8 = ck & 15;
                    *(LAS u32x4*)(HS + pp * PT + 8 * n8) = *(const u32x4*)(sp + pp * 128 + 8 * n8); }
            }
            __syncthreads();
            const float acs_l = ACS[r * 128 + lb * 32 + l32];
            const float dsk = p.in[I_DSKIP][h];
            f32x16 yd = zero16(), yo = zero16();
#pragma unroll
            for (int sb = 0; sb < 4; ++sb) {
                if (sb <= lb) {
                    float lt[16];
#pragma unroll
                    for (int i4 = 0; i4 < 4; ++i4) {
                        const int s0 = sb * 32 + 8 * i4 + 4 * hh;
                        const f32x4 as = *(const LAS f32x4*)(ACS + r * 128 + s0), ds = *(const LAS f32x4*)(DTS + r * 128 + s0);
#pragma unroll
                        for (int j = 0; j < 4; ++j) {
                            float v = cbt[sb][4 * i4 + j] * __expf(fminf(acs_l - as[j], 0.f)) * ds[j];
                            if (sb == lb) { const int sl = 8 * i4 + 4 * hh + j; if (sl > l32) v = 0.f; if (sl == l32) v += dsk; }
                            lt[4 * i4 + j] = v;
                        }
                    }
#pragma unroll
                    for (int t = 0; t < 2; ++t) {
                        const bf16x8 bfrag = pack8(lt[8 * t], lt[8 * t + 1], lt[8 * t + 2], lt[8 * t + 3], lt[8 * t + 4], lt[8 * t + 5], lt[8 * t + 6], lt[8 * t + 7]);
                        const LAS bf16_t* ap = XT + (pb * 32 + l32) * PT + sb * 32 + 16 * t + 4 * hh;
                        const bf16x8 afrag = cat4(*(const LAS s16x4*)ap, *(const LAS s16x4*)(ap + 8));
                        yd = MFMA32(afrag, bfrag, yd);
                    }
                }
            }
#pragma unroll
            for (int t = 0; t < 8; ++t) {
                const bf16x8 a = *(const LAS bf16x8*)(HS + (pb * 32 + l32) * PT + 16 * t + 8 * hh);
                const bf16x8 bb = *(const LAS bf16x8*)(CS + (lb * 32 + l32) * PT + 16 * t + 8 * hh);
                yo = MFMA32(a, bb, yo);
            }
            const float el = __expf(acs_l);
            const int rowg = row0 + lb * 32 + l32;
            float ssq = 0.f;
#pragma unroll
            for (int i4 = 0; i4 < 4; ++i4) {
                bf16_t* zp = proj + (size_t)rowg * LDP + P_Z + 64 * h + pb * 32 + 8 * i4 + 4 * hh;
                const u32x2 zr = *(const u32x2*)zp;
                const float y0 = (yd[4 * i4 + 0] + el * yo[4 * i4 + 0]) * silu_f(bflo(zr.x));
                const float y1 = (yd[4 * i4 + 1] + el * yo[4 * i4 + 1]) * silu_f(bfhi(zr.x));
                const float y2 = (yd[4 * i4 + 2] + el * yo[4 * i4 + 2]) * silu_f(bflo(zr.y));
                const float y3 = (yd[4 * i4 + 3] + el * yo[4 * i4 + 3]) * silu_f(bfhi(zr.y));
                ssq += y0 * y0 + y1 * y1 + y2 * y2 + y3 * y3;
                u32x2 o; o.x = pk2(y0, y1); o.y = pk2(y2, y3); *(u32x2*)zp = o;
            }
            ssq += __shfl_xor(ssq, 32);
            if (hh == 0) ssb[(size_t)rowg * 32 + 2 * h + pb] = ssq;
        }
    }
}

DI void ssd_e_phase(const Params& p) {
    int tid_ = threadIdx.x; asm volatile("" : "+v"(tid_));
    const int tid = tid_, lane = tid & 63, wid = tid >> 6;
    bf16_t* proj = (bf16_t*)(p.ws + WS_PROJ); const float* ssb = (const float*)(p.ws + WS_SS);
    const float* nw = p.in[I_NORMW]; const float* scw = p.in[I_SCW];
    for (int row = blockIdx.x * 8 + wid; row < M; row += gridDim.x * 8) {
        const int t = row & (SEQ - 1);
        float v = lane < 32 ? ssb[(size_t)row * 32 + lane] : 0.f;
        v += __shfl_xor(v, 1); v += __shfl_xor(v, 2); v += __shfl_xor(v, 4); v += __shfl_xor(v, 8);
        const float rs0 = rsqrtf(__shfl(v, 0) * (1.f / 512.f) + RMS_EPS), rs1 = rsqrtf(__shfl(v, 16) * (1.f / 512.f) + RMS_EPS);
        bf16_t* pr = proj + (size_t)row * LDP;
#pragma unroll
        for (int k = 0; k < 2; ++k) {
            const int ch = 512 * k + 8 * lane; const float rs = k ? rs1 : rs0;
            const u32x4 raw = *(const u32x4*)(pr + P_Z + ch);
            const f32x4 w0 = *(const f32x4*)(nw + ch), w1 = *(const f32x4*)(nw + ch + 4);
            u32x4 o;
            o.x = pk2(bflo(raw.x) * rs * w0[0], bfhi(raw.x) * rs * w0[1]); o.y = pk2(bflo(raw.y) * rs * w0[2], bfhi(raw.y) * rs * w0[3]);
            o.z = pk2(bflo(raw.z) * rs * w1[0], bfhi(raw.z) * rs * w1[1]); o.w = pk2(bflo(raw.w) * rs * w1[2], bfhi(raw.w) * rs * w1[3]);
            *(u32x4*)(pr + P_Z + ch) = o;
        }
#pragma unroll
        for (int k = 0; k < 2; ++k) {
            const int ch = 512 * k + 8 * lane;
            float a[8] = {0.f, 0.f, 0.f, 0.f, 0.f, 0.f, 0.f, 0.f};
#pragma unroll
            for (int kk = 0; kk < 3; ++kk) {
                const int tt = t - 2 + kk;
                if (tt >= 0) {
                    const u32x4 raw = *(const u32x4*)(pr + (ptrdiff_t)(kk - 2) * LDP + P_PROD + ch);
                    const f32x4 w0 = *(const f32x4*)(scw + kk * 1024 + ch), w1 = *(const f32x4*)(scw + kk * 1024 + ch + 4);
                    a[0] += w0[0] * bflo(raw.x); a[1] += w0[1] * bfhi(raw.x); a[2] += w0[2] * bflo(raw.y); a[3] += w0[3] * bfhi(raw.y);
                    a[4] += w1[0] * bflo(raw.z); a[5] += w1[1] * bfhi(raw.z); a[6] += w1[2] * bflo(raw.w); a[7] += w1[3] * bfhi(raw.w);
                }
            }
            const u32x4 sb = *(const u32x4*)(pr + P_SCB + ch);
            u32x4 o;
            o.x = pk2(bflo(sb.x) * a[0], bfhi(sb.x) * a[1]); o.y = pk2(bflo(sb.y) * a[2], bfhi(sb.y) * a[3]);
            o.z = pk2(bflo(sb.z) * a[4], bfhi(sb.z) * a[5]); o.w = pk2(bflo(sb.w) * a[6], bfhi(sb.w) * a[7]);
            *(u32x4*)(pr + P_SCB + ch) = o;
        }
    }
}

DI void ln_phase(const Params& p, const float* gam, const float* bet, const float* psrc) {
    int tid_ = threadIdx.x; asm volatile("" : "+v"(tid_));
    const int tid = tid_, lane = tid & 63, wid = tid >> 6;
    float* X = p.out; bf16_t* xb = (bf16_t*)(p.ws + WS_XB);
    for (int row = blockIdx.x * 8 + wid; row < M; row += gridDim.x * 8) {
        f32x4* xr = (f32x4*)(X + (size_t)row * DM) + lane;
        f32x4 v[4]; float s = 0.f;
#pragma unroll
        for (int j = 0; j < 4; ++j) { v[j] = xr[64 * j]; s += (v[j][0] + v[j][1]) + (v[j][2] + v[j][3]); }
#pragma unroll
        for (int o = 1; o < 64; o <<= 1) s += __shfl_xor(s, o);
        const float mean = s * (1.f / DM); float s2 = 0.f;
#pragma unroll
        for (int j = 0; j < 4; ++j) { v[j] = v[j] - mean; s2 += (v[j][0] * v[j][0] + v[j][1] * v[j][1]) + (v[j][2] * v[j][2] + v[j][3] * v[j][3]); }
#pragma unroll
        for (int o = 1; o < 64; o <<= 1) s2 += __shfl_xor(s2, o);
        const float rstd = rsqrtf(s2 * (1.f / DM) + LN_EPS);
        u32x2* ob = (u32x2*)(xb + (size_t)row * DM) + lane;
#pragma unroll
        for (int j = 0; j < 4; ++j) {
            const f32x4 gv = *((const f32x4*)gam + lane + 64 * j), bv = *((const f32x4*)bet + lane + 64 * j);
            const f32x4 y = v[j] * rstd * gv + bv;
            xr[64 * j] = y;
            u32x2 o; o.x = pk2(y[0], y[1]); o.y = pk2(y[2], y[3]); ob[64 * j] = o;
        }
    }
    if (psrc) cvt_rows_bf16(psrc, (bf16_t*)(p.ws + WS_PB), (size_t)M * PLE_DIM / 8, blockIdx.x * NTHR + tid, gridDim.x * NTHR);
}

DI void attn_phase(const Params& p, LAS unsigned char* lds) {
    int tid_ = threadIdx.x; asm volatile("" : "+v"(tid_));
    const int tid = tid_, lane = tid & 63, wid = tid >> 6, l32 = lane & 31, hh = lane >> 5;
    constexpr int KP = 72, VP = 264;
    LAS bf16_t* KS = (LAS bf16_t*)lds;
    LAS bf16_t* VT = (LAS bf16_t*)(lds + 36864);
    const bf16_t* qkv = (const bf16_t*)(p.ws + WS_QKVB); bf16_t* ob = (bf16_t*)(p.ws + WS_OB);
    for (int unit = blockIdx.x; unit < 512; unit += gridDim.x) {
        const int b = unit >> 6, nb = (unit >> 2) & 15, kvh = unit & 3;
        __syncthreads();
        for (int id = tid; id < 2048; id += NTHR) {
            const int s = id >> 3, c8 = id & 7; u32x4 v = {0u, 0u, 0u, 0u};
            if (nb > 0 || s >= 128) v = *(const u32x4*)(qkv + (size_t)(b * SEQ + (nb - 1) * 128 + s) * QKV + 1024 + 64 * kvh + 8 * c8);
            *(LAS u32x4*)(KS + s * KP + 8 * c8) = v;
        }
        for (int id = tid; id < 2048; id += NTHR) {
            const int s = id & 255, c8 = id >> 8; u32x4 v = {0u, 0u, 0u, 0u};
            if (nb > 0 || s >= 128) v = *(const u32x4*)(qkv + (size_t)(b * SEQ + (nb - 1) * 128 + s) * QKV + 1280 + 64 * kvh + 8 * c8);
            LAS bf16_t* d = VT + (8 * c8) * VP + s;
            d[0 * VP] = (bf16_t)(v.x & 0xffffu); d[1 * VP] = (bf16_t)(v.x >> 16); d[2 * VP] = (bf16_t)(v.y & 0xffffu); d[3 * VP] = (bf16_t)(v.y >> 16);
            d[4 * VP] = (bf16_t)(v.z & 0xffffu); d[5 * VP] = (bf16_t)(v.z >> 16); d[6 * VP] = (bf16_t)(v.w & 0xffffu); d[7 * VP] = (bf16_t)(v.w >> 16);
        }
        __syncthreads();
        const int gq = wid >> 1, qhalf = wid & 1, h = kvh * 4 + gq;
        const float sink = p.in[I_SINK][h];
#pragma unroll 1
        for (int qq = 0; qq < 2; ++qq) {
            const int qb = 2 * qhalf + qq, q = 32 * qb + l32;
            const size_t qrow = (size_t)(b * SEQ + nb * 128 + q);
            bf16x8 qf[4];
#pragma unroll
            for (int t = 0; t < 4; ++t) qf[t] = *(const bf16x8*)(qkv + qrow * QKV + 64 * h + 16 * t + 8 * hh);
            f32x16 st[5];
#pragma unroll
            for (int kk = 0; kk < 5; ++kk) {
                st[kk] = zero16();
#pragma unroll
                for (int t = 0; t < 4; ++t) {
                    const bf16x8 a = *(const LAS bf16x8*)(KS + (32 * (qb + kk) + l32) * KP + 16 * t + 8 * hh);
                    st[kk] = MFMA32(a, qf[t], st[kk]);
                }
            }
            float mx = sink;
#pragma unroll
            for (int kk = 0; kk < 5; ++kk)
#pragma unroll
                for (int i = 0; i < 16; ++i) {
                    const int s = 32 * (qb + kk) + crow(i, hh);
                    const bool valid = (s > q) && (s <= q + 128) && (nb > 0 || s >= 128);
                    const float v = valid ? st[kk][i] * 0.125f : -INFINITY;
                    st[kk][i] = v; mx = fmaxf(mx, v);
                }
            mx = fmaxf(mx, __shfl_xor(mx, 32));
            float sum = 0.f;
#pragma unroll
            for (int kk = 0; kk < 5; ++kk)
#pragma unroll
                for (int i = 0; i < 16; ++i) { const float e = __expf(st[kk][i] - mx); st[kk][i] = e; sum += e; }
            sum += __shfl_xor(sum, 32);
            sum += __expf(sink - mx);
            const float inv = 1.f / sum;
            f32x16 ot[2]; ot[0] = zero16(); ot[1] = zero16();
#pragma unroll
            for (int kk = 0; kk < 5; ++kk)
#pragma unroll
                for (int t = 0; t < 2; ++t) {
                    const bf16x8 bfrag = pack8(st[kk][8 * t], st[kk][8 * t + 1], st[kk][8 * t + 2], st[kk][8 * t + 3], st[kk][8 * t + 4], st[kk][8 * t + 5], st[kk][8 * t + 6], st[kk][8 * t + 7]);
#pragma unroll
                    for (int db = 0; db < 2; ++db) {
                        const LAS bf16_t* ap = VT + (32 * db + l32) * VP + 32 * (qb + kk) + 16 * t + 4 * hh;
                        const bf16x8 afrag = cat4(*(const LAS s16x4*)ap, *(const LAS s16x4*)(ap + 8));
                        ot[db] = MFMA32(afrag, bfrag, ot[db]);
                    }
                }
#pragma unroll
            for (int db = 0; db < 2; ++db)
#pragma unroll
                for (int i4 = 0; i4 < 4; ++i4) {
                    u32x2 o; o.x = pk2(ot[db][4 * i4] * inv, ot[db][4 * i4 + 1] * inv); o.y = pk2(ot[db][4 * i4 + 2] * inv, ot[db][4 * i4 + 3] * inv);
                    *(u32x2*)(ob + qrow * DM + 64 * h + 32 * db + 8 * i4 + 4 * hh) = o;
                }
        }
    }
}

__global__ void __launch_bounds__(NTHR) fwd_megakernel(Params p) {
    extern __shared__ __attribute__((aligned(16))) unsigned char smem[];
    LAS unsigned char* lds = (LAS unsigned char*)smem;
    cg::grid_group grid = cg::this_grid();
    unsigned char* ws = p.ws;
    const int G = gridDim.x, bid = blockIdx.x;
    int ph = 0;
#define PHASE_BEGIN if (ph >= p.ph_lo && ph < p.ph_hi) {
#define PHASE_END   if (ph + 1 < p.ph_hi) grid.sync(); } ++ph;

    PHASE_BEGIN prologue_phase(p, lds); PHASE_END
    PHASE_BEGIN {
        pg8::Gemm g{(const bf16_t*)(ws + WS_XB), (const bf16_t*)(ws + WS_WIN), M, N_IN, DM, DM}; pg8::StaticOrder S; S.init(M, N_IN, G, bid);
        EpiIn E{(bf16_t*)(ws + WS_PROJ), (float*)(ws + WS_DTRAW)};
        pg8::gemm_phase(lds, g, S, E);
    } PHASE_END
    PHASE_BEGIN ssd_s1_phase(p, lds); PHASE_END
    PHASE_BEGIN ssd_scan_phase(p); PHASE_END
    PHASE_BEGIN ssd_s3_phase(p, lds); PHASE_END
    PHASE_BEGIN ssd_e_phase(p); PHASE_END
    PHASE_BEGIN {
        pg8::Gemm g{(const bf16_t*)(ws + WS_PROJ), (const bf16_t*)(ws + WS_WOUT), M, DM, 2048, LDP}; pg8::StaticOrder S; S.init(M, DM, G, bid);
        EpiRes E{p.in[I_X], p.out, nullptr};
        pg8::gemm_phase(lds, g, S, E);
    } PHASE_END
#pragma unroll 1
    for (int layer = 0; layer < 2; ++layer) {
        if (layer == 1) {
            PHASE_BEGIN {
                pg8::Gemm g{(const bf16_t*)(ws + WS_XB), (const bf16_t*)(ws + WS_WQKV), M, QKV, DM, DM}; pg8::StaticOrder S; S.init(M, QKV, G, bid);
                EpiBf E{(bf16_t*)(ws + WS_QKVB), QKV, p.in[I_BQKV]};
                pg8::gemm_phase(lds, g, S, E);
            } PHASE_END
            PHASE_BEGIN attn_phase(p, lds); PHASE_END
            PHASE_BEGIN {
                pg8::Gemm g{(const bf16_t*)(ws + WS_OB), (const bf16_t*)(ws + WS_WO), M, DM, DM, DM}; pg8::StaticOrder S; S.init(M, DM, G, bid);
                EpiRes E{p.out, p.out, p.in[I_BO]};
                pg8::gemm_phase(lds, g, S, E);
            } PHASE_END
        }
        PHASE_BEGIN ln_phase(p, p.in[I_LNMG] + layer * DM, p.in[I_LNMB] + layer * DM, p.in[I_P] + (size_t)layer * M * PLE_DIM); PHASE_END
        PHASE_BEGIN {
            {
                pg8::Gemm g{(const bf16_t*)(ws + WS_XB), (const bf16_t*)(ws + WS_WGU0 + layer * SZ_WGU), M, 2 * DFF, DM, DM}; pg8::StaticOrder S; S.init(M, 2 * DFF, G, bid);
                EpiGlu E{(bf16_t*)(ws + WS_H)};
                pg8::gemm_phase(lds, g, S, E);
            }
            {
                pg8::Gemm g{(const bf16_t*)(ws + WS_PB), (const bf16_t*)(ws + WS_WPL0 + layer * SZ_WPL), M, DM, PLE_DIM, PLE_DIM}; pg8::StaticOrder S; S.init(M, DM, G, bid);
                EpiBf E{(bf16_t*)(ws + WS_U), DM, nullptr};
                pg8::gemm_phase(lds, g, S, E);
            }
        } PHASE_END
        PHASE_BEGIN {
            pg8::Gemm g{(const bf16_t*)(ws + WS_H), (const bf16_t*)(ws + WS_WDN0 + layer * SZ_WDN), M, DM, DFF, DFF}; pg8::StaticOrder S; S.init(M, DM, G, bid);
            EpiRes E{p.out, p.out, nullptr};
            pg8::gemm_phase(lds, g, S, E);
        } PHASE_END
        PHASE_BEGIN ln_phase(p, p.in[I_LNFG] + layer * DM, p.in[I_LNFB] + layer * DM, nullptr); PHASE_END
        PHASE_BEGIN {
            pg8::Gemm g{(const bf16_t*)(ws + WS_XB), (const bf16_t*)(ws + WS_WPG0 + layer * SZ_WPG), M, DM, DM, DM}; pg8::StaticOrder S; S.init(M, DM, G, bid);
            EpiPle E{p.out, (const bf16_t*)(ws + WS_U), p.in[I_BPG] + layer * DM, (bf16_t*)(ws + WS_XB)};
            pg8::gemm_phase(lds, g, S, E);
        } PHASE_END
    }
#undef PHASE_BEGIN
#undef PHASE_END
}

constexpr int N_PHASES = 7 + 5 + 3 + 5;

extern "C" void kernel_launch(void* const* d_in, const int* in_sizes, int n_in, void* d_out, int out_size, void* d_ws, size_t ws_size, hipStream_t stream) {
    static int grid = 0;
    if (grid == 0) {
        if (n_in != 26 || out_size != M * DM || ws_size < WS_END) { fprintf(stderr, "kernel_launch: unexpected shapes: n_in %d out %d ws %zu (need %zu)\n", n_in, out_size, ws_size, (size_t)WS_END); grid = -1; return; }
        int dev = 0, cus = 0, per_cu = 0;
        hipGetDevice(&dev);
        hipDeviceGetAttribute(&cus, hipDeviceAttributeMultiprocessorCount, dev);
        hipFuncSetAttribute((const void*)fwd_megakernel, hipFuncAttributeMaxDynamicSharedMemorySize, LDS_BYTES);
        hipOccupancyMaxActiveBlocksPerMultiprocessor(&per_cu, (const void*)fwd_megakernel, NTHR, LDS_BYTES);
        if (per_cu < 1) { fprintf(stderr, "kernel_launch: occupancy query says %d blocks/CU\n", per_cu); per_cu = 1; }
        (void)hipGetLastError();
        grid = cus;
    }
    if (grid < 0) return;
    Params p{};
    for (int i = 0; i < 26; ++i) p.in[i] = (const float*)d_in[i];
    p.out = (float*)d_out; p.ws = (unsigned char*)d_ws; p.ph_lo = 0; p.ph_hi = N_PHASES;
    void* args[] = {&p};
    hipError_t e = hipLaunchCooperativeKernel((const void*)fwd_megakernel, dim3(grid), dim3(NTHR), args, LDS_BYTES, stream);
    if (e != hipSuccess) fprintf(stderr, "cooperative launch failed: %s (grid %d)\n", hipGetErrorString(e), grid);
}
```

```cpp
#include <hip/hip_runtime.h>
#include <hip/hip_cooperative_groups.h>
#include <cstdio>
#include <cstdint>
namespace cg = cooperative_groups;

#define LAS __attribute__((address_space(3)))
#define DI __device__ __forceinline__
typedef unsigned short bf16_t;
typedef short bf16x8 __attribute__((ext_vector_type(8)));
typedef short s16x4 __attribute__((ext_vector_type(4)));
typedef float f32x4 __attribute__((ext_vector_type(4)));
typedef float f32x2 __attribute__((ext_vector_type(2)));
typedef float f32x16 __attribute__((ext_vector_type(16)));
typedef unsigned u32x4 __attribute__((ext_vector_type(4)));
typedef unsigned u32x2 __attribute__((ext_vector_type(2)));
typedef __bf16 bf16x2_t __attribute__((ext_vector_type(2)));

constexpr int NBATCH = 8, SEQ = 2048, DM = 1024, M = NBATCH * SEQ;
constexpr int PLE_DIM = 256, DFF = 2816;
constexpr int MIX_IN = 5648, XBC = 1536;
constexpr int LDP = 4608;
constexpr int P_Z = 0, P_SCB = 1024, P_XBC = 2048, P_PROD = 3584;
constexpr int N_IN = 5888;
constexpr int QKV = 1536;
constexpr float ALPHA = 1.4142135623730951f;
constexpr float LN_EPS = 1e-5f, RMS_EPS = 1e-5f;
constexpr int NTHR = 512;
constexpr int LDS_STAGE = 131072;
constexpr int LDS_BYTES = LDS_STAGE + 64;

constexpr size_t WS_WIN = 0;
constexpr size_t WS_WOUT = WS_WIN + (size_t)N_IN * DM * 2;
constexpr size_t WS_WGU0 = WS_WOUT + (size_t)DM * 2048 * 2;
constexpr size_t SZ_WGU = (size_t)2 * DFF * DM * 2;
constexpr size_t WS_WDN0 = WS_WGU0 + 2 * SZ_WGU;
constexpr size_t SZ_WDN = (size_t)DM * DFF * 2;
constexpr size_t WS_WPG0 = WS_WDN0 + 2 * SZ_WDN;
constexpr size_t SZ_WPG = (size_t)DM * DM * 2;
constexpr size_t WS_WPL0 = WS_WPG0 + 2 * SZ_WPG;
constexpr size_t SZ_WPL = (size_t)DM * PLE_DIM * 2;
constexpr size_t WS_WQKV = WS_WPL0 + 2 * SZ_WPL;
constexpr size_t WS_WO = WS_WQKV + (size_t)QKV * DM * 2;
constexpr size_t WS_XB = WS_WO + (size_t)DM * DM * 2;
constexpr size_t WS_DTRAW = WS_XB + (size_t)M * DM * 2;
constexpr size_t WS_DTV = WS_DTRAW + (size_t)M * 16 * 4;
constexpr size_t WS_ACS = WS_DTV + (size_t)M * 16 * 4;
constexpr size_t WS_SS = WS_ACS + (size_t)M * 16 * 4;
constexpr size_t WS_CDEC = WS_SS + (size_t)M * 32 * 4;
constexpr size_t WS_CTL = WS_CDEC + 32768;
constexpr size_t CTL_BYTES = 16384;
constexpr size_t WS_PROJ = WS_CDEC + 65536;
constexpr size_t MiB = 1u << 20;
constexpr size_t WS_H = WS_PROJ;
constexpr size_t WS_U = WS_PROJ + 96 * MiB;
constexpr size_t WS_PB = WS_PROJ + 128 * MiB;
constexpr size_t WS_QKVB = WS_PROJ;
constexpr size_t WS_OB = WS_PROJ + 48 * MiB;
constexpr size_t WS_END = WS_PROJ + (size_t)M * LDP * 2;
static_assert(WS_END <= 268435456, "workspace map exceeds 256 MiB");
static_assert(WS_PB + (size_t)M * 256 * 2 <= WS_END, "pb fits");

DI unsigned pk2(float lo, float hi) { f32x2 v = {lo, hi}; bf16x2_t b = __builtin_convertvector(v, bf16x2_t); return __builtin_bit_cast(unsigned, b); }
DI float bflo(unsigned u) { return __uint_as_float(u << 16); }
DI float bfhi(unsigned u) { return __uint_as_float(u & 0xffff0000u); }
DI bf16_t f2bf(float f) { return (bf16_t)(pk2(f, 0.f) & 0xffffu); }
DI float silu_f(float x) { return x * __builtin_amdgcn_rcpf(1.f + __expf(-x)); }
DI float sigmoid_f(float x) { return __builtin_amdgcn_rcpf(1.f + __expf(-x)); }
DI int crow(int reg, int h) { return (reg & 3) + 8 * (reg >> 2) + 4 * h; }
#define MFMA32(a, b, c) __builtin_amdgcn_mfma_f32_32x32x16_bf16((a), (b), (c), 0, 0, 0)
DI f32x16 zero16() { f32x16 z; for (int i = 0; i < 16; ++i) z[i] = 0.f; return z; }
DI bf16x8 pack8(float a0, float a1, float a2, float a3, float a4, float a5, float a6, float a7) {
    u32x4 p; p.x = pk2(a0, a1); p.y = pk2(a2, a3); p.z = pk2(a4, a5); p.w = pk2(a6, a7); return __builtin_bit_cast(bf16x8, p);
}
DI bf16x8 cat4(s16x4 lo, s16x4 hi) { bf16x8 r; r[0] = lo[0]; r[1] = lo[1]; r[2] = lo[2]; r[3] = lo[3]; r[4] = hi[0]; r[5] = hi[1]; r[6] = hi[2]; r[7] = hi[3]; return r; }

namespace pg8 {
constexpr int BM = 256, BK = 64, HALF = 128, HTB = HALF * BK * 2, STAGE_BYTES = 8 * HTB, NXCD = 8, WGM = 8;
__host__ __device__ __forceinline__ int lds_byte(int r, int c) { const int st = (r >> 4) * 2 + (c >> 5), rr = r & 15, cc = c & 31, ob = rr * 64 + cc * 2; return st * 1024 + (ob ^ (((ob >> 9) & 1) << 5)); }
__host__ __device__ __forceinline__ void stage_rc(int b, int& R, int& C) { const int st = b / 1024, sb = b % 1024, swz = sb ^ (((sb >> 9) & 1) << 5); R = (st >> 1) * 16 + swz / 64; C = (st & 1) * 32 + (swz % 64) / 2; }
__host__ __device__ __forceinline__ int perm32(int rho) { const int n = rho >> 4, i = rho & 15; return 8 * (i >> 2) + 4 * n + (i & 3); }

struct Unit { int pm, pn; };
struct Gemm { const bf16_t* A; const bf16_t* Bt; int M, N, K, lda; };

struct StaticOrder {
    int nM, nN, nwg, G, c;
    __host__ __device__ void init(int M_, int N_, int G_, int c_) { nM = M_ / BM; nN = N_ / BM; nwg = nM * nN; G = G_; c = c_; }
    __host__ __device__ bool next(int i, Unit& u) const {
        const long L = (long)i * G + c; if (L >= nwg) return false;
        int wgid = (int)L; { const int q = nwg / NXCD, r = nwg % NXCD, xcd = wgid % NXCD, off = wgid / NXCD; wgid = (xcd < r ? xcd * (q + 1) : r * (q + 1) + (xcd - r) * q) + off; }
        const int nig = WGM * nN, gid = wgid / nig, fm = gid * WGM, gsz = (nM - fm) < WGM ? (nM - fm) : WGM;
        u.pm = fm + ((wgid % nig) % gsz); u.pn = (wgid % nig) / gsz; return true;
    }
};

template <class Epi>
__device__ __forceinline__ void gemm_phase(LAS unsigned char* lds, const Gemm g, const StaticOrder& S, const Epi& E) {
    int tid_ = threadIdx.x; asm volatile("" : "+v"(tid_));
    const int tid = tid_, wid = __builtin_amdgcn_readfirstlane(tid >> 6), lane = tid & 63, wr = wid >> 2, wc = wid & 3, fr = lane & 15, fq = lane >> 4;
    const int K = g.K, nt = K / BK, lda = g.lda;
    unsigned voffA[2], voffB[2];
#pragma unroll
    for (int i = 0; i < 2; ++i) { int R, C; stage_rc(tid * 16 + i * 8192, R, C); const int Rb = (R & ~31) + perm32(R & 31);
        voffA[i] = (unsigned)(R * lda + C) * 2u; voffB[i] = (unsigned)(Rb * K + C) * 2u; }
    const size_t kstep = (size_t)(BK * 2);
    const size_t hstepA = (size_t)HALF * lda * 2, hstepB = (size_t)HALF * K * 2;
    const size_t tstepA = 2 * hstepA, tstepB = 2 * hstepB;
    const unsigned ldsw = (unsigned)wid * 1024u;
    const int aoff = lds_byte(wr * 64 + fr, fq * 8), boff = lds_byte(wc * 32 + fr, fq * 8);
#define PG8_SA(b, h) (((b) * 2 + (h)) * HTB)
#define PG8_SB(b, h) ((4 + (b) * 2 + (h)) * HTB)
#define PG8_STAGE(bufoff, gbase, voff) do { _Pragma("unroll") for (int _i = 0; _i < 2; ++_i) \
        __builtin_amdgcn_global_load_lds((const unsigned*)((const char*)(gbase) + (voff)[_i]), (LAS unsigned*)(lds + (bufoff) + ldsw + _i * 8192), 16, 0, 0); } while (0)
#define PG8_LDA(dst, b, h) do { _Pragma("unroll") for (int m = 0; m < 4; ++m) _Pragma("unroll") for (int k = 0; k < 2; ++k) dst[m][k] = *(const LAS bf16x8*)(lds + PG8_SA(b, h) + aoff + m * 2048 + k * 1024); } while (0)
#define PG8_LDB(dst, b, h) do { _Pragma("unroll") for (int n = 0; n < 2; ++n) _Pragma("unroll") for (int k = 0; k < 2; ++k) dst[n][k] = *(const LAS bf16x8*)(lds + PG8_SB(b, h) + boff + n * 2048 + k * 1024); } while (0)
#define PG8_MMA(ai, bj, At, Bt) do { __builtin_amdgcn_s_setprio(1); _Pragma("unroll") for (int m = 0; m < 4; ++m) _Pragma("unroll") for (int n = 0; n < 2; ++n) _Pragma("unroll") for (int k = 0; k < 2; ++k) \
        acc[ai][bj][m][n] = __builtin_amdgcn_mfma_f32_16x16x32_bf16(Bt[n][k], At[m][k], acc[ai][bj][m][n], 0, 0, 0); __builtin_amdgcn_s_setprio(0); } while (0)
#define PG8_WAIT_V(n) asm volatile("s_waitcnt vmcnt(" #n ")" ::: "memory")
#define PG8_WAIT_L(n) asm volatile("s_waitcnt lgkmcnt(" #n ")" ::: "memory")
#define PG8_BAR __builtin_amdgcn_s_barrier()
#define PG8_SCHED __builtin_amdgcn_sched_barrier(0)
    Unit cur, nxt; int ui = 0;
    if (!S.next(0, cur)) return;
    f32x4 acc[2][2][4][2];
#pragma unroll
    for (int a = 0; a < 2; ++a)
#pragma unroll
        for (int b = 0; b < 2; ++b)
#pragma unroll
            for (int m = 0; m < 4; ++m)
#pragma unroll
                for (int n = 0; n < 2; ++n) acc[a][b][m][n] = (f32x4){0.f, 0.f, 0.f, 0.f};
    bf16x8 At[4][2], B0[2][2], B1[2][2];
    const char* cA = (const char*)g.A + (size_t)cur.pm * tstepA; const char* cB = (const char*)g.Bt + (size_t)cur.pn * tstepB;
    {
        PG8_STAGE(PG8_SB(0, 0), cB, voffB); PG8_STAGE(PG8_SB(0, 1), cB + hstepB, voffB); PG8_STAGE(PG8_SA(0, 0), cA, voffA); PG8_STAGE(PG8_SA(0, 1), cA + hstepA, voffA);
        if (wr == 1) PG8_BAR;
        PG8_WAIT_V(2); PG8_BAR;
        PG8_STAGE(PG8_SB(1, 0), cB + kstep, voffB); PG8_STAGE(PG8_SA(1, 0), cA + kstep, voffA); PG8_STAGE(PG8_SB(1, 1), cB + hstepB + kstep, voffB);
        PG8_WAIT_V(6); PG8_BAR;
    }
    for (;;) {
        const bool has_next = S.next(ui + 1, nxt);
        const char* nA = has_next ? (const char*)g.A + (size_t)nxt.pm * tstepA : cA; const char* nB = has_next ? (const char*)g.Bt + (size_t)nxt.pn * tstepB : cB;
#pragma unroll 1
        for (int t = 0; t < nt; t += 2) {
            const bool last = (t == nt - 2);
            const char* a1 = cA + (size_t)(t + 1) * kstep;
            const char* a2 = last ? nA : cA + (size_t)(t + 2) * kstep; const char* b2 = last ? nB : cB + (size_t)(t + 2) * kstep;
            const char* a3 = a2 + kstep; const char* b3 = b2 + kstep;
            PG8_LDB(B0, 0, 0); PG8_LDB(B1, 0, 1); PG8_SCHED; PG8_LDA(At, 0, 0); PG8_STAGE(PG8_SA(1, 1), a1 + hstepA, voffA);
            PG8_WAIT_V(8); PG8_WAIT_L(0); PG8_BAR; PG8_MMA(0, 0, At, B0); PG8_MMA(0, 1, At, B1); PG8_BAR; PG8_SCHED;
            PG8_LDA(At, 0, 1); PG8_STAGE(PG8_SB(0, 0), b2, voffB); PG8_STAGE(PG8_SB(0, 1), b2 + hstepB, voffB); PG8_STAGE(PG8_SA(0, 0), a2, voffA);
            PG8_WAIT_V(8); PG8_WAIT_L(0); PG8_BAR; PG8_MMA(1, 0, At, B0); PG8_MMA(1, 1, At, B1); PG8_BAR; PG8_SCHED;
            PG8_LDB(B0, 1, 0); PG8_LDB(B1, 1, 1); PG8_SCHED; PG8_LDA(At, 1, 0); PG8_STAGE(PG8_SA(0, 1), a2 + hstepA, voffA);
            PG8_WAIT_V(8); PG8_WAIT_L(0); PG8_BAR; PG8_MMA(0, 0, At, B0); PG8_MMA(0, 1, At, B1); PG8_BAR; PG8_SCHED;
            PG8_LDA(At, 1, 1); PG8_STAGE(PG8_SB(1, 0), b3, voffB); PG8_STAGE(PG8_SB(1, 1), b3 + hstepB, voffB); PG8_STAGE(PG8_SA(1, 0), a3, voffA);
            PG8_WAIT_V(8); PG8_WAIT_L(0); PG8_BAR; PG8_MMA(1, 0, At, B0); PG8_MMA(1, 1, At, B1); PG8_BAR; PG8_SCHED;
        }
        if (wr == 0) PG8_BAR;
        E(acc, cur, wr, wc, fr, fq);
        if (!has_next) break;
#pragma unroll
        for (int a = 0; a < 2; ++a)
#pragma unroll
            for (int b = 0; b < 2; ++b)
#pragma unroll
                for (int m = 0; m < 4; ++m)
#pragma unroll
                    for (int n = 0; n < 2; ++n) acc[a][b][m][n] = (f32x4){0.f, 0.f, 0.f, 0.f};
        cur = nxt; cA = nA; cB = nB; ++ui;
        if (wr == 1) PG8_BAR;
    }
    PG8_WAIT_V(0);
    PG8_BAR;
#undef PG8_SA
#undef PG8_SB
#undef PG8_STAGE
#undef PG8_LDA
#undef PG8_LDB
#undef PG8_MMA
#undef PG8_WAIT_V
#undef PG8_WAIT_L
#undef PG8_BAR
#undef PG8_SCHED
}
}
using pg8::Unit;
typedef f32x4 AccT[2][2][4][2];

DI void store8bf(bf16_t* p, f32x4 v0, f32x4 v1) { u32x4 w; w.x = pk2(v0[0], v0[1]); w.y = pk2(v0[2], v0[3]); w.z = pk2(v1[0], v1[1]); w.w = pk2(v1[2], v1[3]); *(u32x4*)p = w; }

struct EpiIn {
    bf16_t* proj; float* dtraw;
    DI void operator()(const AccT& acc, const Unit& u, int wr, int wc, int fr, int fq) const {
        const int row0 = u.pm * 256 + wr * 64 + fr;
        if (u.pn < 14) {
            const int col0 = u.pn * 256 + wc * 32 + 8 * fq;
#pragma unroll
            for (int ai = 0; ai < 2; ++ai)
#pragma unroll
                for (int m = 0; m < 4; ++m) { bf16_t* rp = proj + (size_t)(row0 + ai * 128 + m * 16) * LDP + col0;
#pragma unroll
                    for (int bj = 0; bj < 2; ++bj) store8bf(rp + bj * 128, acc[ai][bj][m][0], acc[ai][bj][m][1]); }
        } else if (u.pn < 22) {
            const int col0 = P_PROD + (u.pn - 14) * 128 + wc * 32 + 8 * fq;
#pragma unroll
            for (int ai = 0; ai < 2; ++ai)
#pragma unroll
                for (int m = 0; m < 4; ++m) { bf16_t* rp = proj + (size_t)(row0 + ai * 128 + m * 16) * LDP + col0;
                    store8bf(rp, acc[ai][0][m][0] * acc[ai][1][m][0], acc[ai][0][m][1] * acc[ai][1][m][1]); }
        } else {
            if (wc == 0 && fq < 2) {
#pragma unroll
                for (int ai = 0; ai < 2; ++ai)
#pragma unroll
                    for (int m = 0; m < 4; ++m) { float* rp = dtraw + (size_t)(row0 + ai * 128 + m * 16) * 16 + 8 * fq;
                        *(f32x4*)rp = acc[ai][0][m][0]; *(f32x4*)(rp + 4) = acc[ai][0][m][1]; }
            }
        }
    }
};
struct EpiGlu {
    bf16_t* h;
    DI void operator()(const AccT& acc, const Unit& u, int wr, int wc, int fr, int fq) const {
        const int row0 = u.pm * 256 + wr * 64 + fr, col0 = u.pn * 128 + wc * 32 + 8 * fq;
#pragma unroll
        for (int ai = 0; ai < 2; ++ai)
#pragma unroll
            for (int m = 0; m < 4; ++m) { bf16_t* rp = h + (size_t)(row0 + ai * 128 + m * 16) * DFF + col0;
                f32x4 v0, v1;
#pragma unroll
                for (int i = 0; i < 4; ++i) { v0[i] = silu_f(acc[ai][0][m][0][i]) * acc[ai][1][m][0][i]; v1[i] = silu_f(acc[ai][0][m][1][i]) * acc[ai][1][m][1][i]; }
                store8bf(rp, v0, v1); __builtin_amdgcn_sched_barrier(0); }
    }
};
struct EpiRes {
    const float* res; float* out; const float* bias;
    DI void operator()(const AccT& acc, const Unit& u, int wr, int wc, int fr, int fq) const {
        const int row0 = u.pm * 256 + wr * 64 + fr, col0 = u.pn * 256 + wc * 32 + 8 * fq;
#pragma unroll
        for (int bj = 0; bj < 2; ++bj) {
            f32x4 b0 = {0.f, 0.f, 0.f, 0.f}, b1 = {0.f, 0.f, 0.f, 0.f};
            if (bias) { b0 = *(const f32x4*)(bias + col0 + bj * 128); b1 = *(const f32x4*)(bias + col0 + bj * 128 + 4); }
#pragma unroll
            for (int ai = 0; ai < 2; ++ai)
#pragma unroll
                for (int m = 0; m < 4; ++m) { const size_t o = (size_t)(row0 + ai * 128 + m * 16) * DM + col0 + bj * 128;
                    const f32x4 r0 = *(const f32x4*)(res + o), r1 = *(const f32x4*)(res + o + 4);
                    *(f32x4*)(out + o) = r0 * ALPHA + acc[ai][bj][m][0] + b0; *(f32x4*)(out + o + 4) = r1 * ALPHA + acc[ai][bj][m][1] + b1; if (m & 1) __builtin_amdgcn_sched_barrier(0); }
        }
    }
};
struct EpiBf {
    bf16_t* out; int ldc; const float* bias;
    DI void operator()(const AccT& acc, const Unit& u, int wr, int wc, int fr, int fq) const {
        const int row0 = u.pm * 256 + wr * 64 + fr, col0 = u.pn * 256 + wc * 32 + 8 * fq;
#pragma unroll
        for (int bj = 0; bj < 2; ++bj) {
            f32x4 b0 = {0.f, 0.f, 0.f, 0.f}, b1 = {0.f, 0.f, 0.f, 0.f};
            if (bias) { b0 = *(const f32x4*)(bias + col0 + bj * 128); b1 = *(const f32x4*)(bias + col0 + bj * 128 + 4); }
#pragma unroll
            for (int ai = 0; ai < 2; ++ai)
#pragma unroll
                for (int m = 0; m < 4; ++m)
                    store8bf(out + (size_t)(row0 + ai * 128 + m * 16) * ldc + col0 + bj * 128, acc[ai][bj][m][0] + b0, acc[ai][bj][m][1] + b1);
        }
    }
};
struct EpiPle {
    float* X; const bf16_t* U; const float* bias; bf16_t* xb;
    DI void operator()(const AccT& acc, const Unit& u, int wr, int wc, int fr, int fq) const {
        const int row0 = u.pm * 256 + wr * 64 + fr, col0 = u.pn * 256 + wc * 32 + 8 * fq;
#pragma unroll
        for (int bj = 0; bj < 2; ++bj) {
            const f32x4 b0 = *(const f32x4*)(bias + col0 + bj * 128), b1 = *(const f32x4*)(bias + col0 + bj * 128 + 4);
#pragma unroll
            for (int ai = 0; ai < 2; ++ai)
#pragma unroll
                for (int m = 0; m < 4; ++m) { const size_t o = (size_t)(row0 + ai * 128 + m * 16) * DM + col0 + bj * 128;
                    const u32x4 ur = *(const u32x4*)(U + o);
                    const f32x4 x0 = *(const f32x4*)(X + o), x1 = *(const f32x4*)(X + o + 4);
                    const f32x4 a0 = acc[ai][bj][m][0] + b0, a1 = acc[ai][bj][m][1] + b1;
                    f32x4 y0, y1;
                    y0[0] = x0[0] + bflo(ur.x) * sigmoid_f(a0[0]); y0[1] = x0[1] + bfhi(ur.x) * sigmoid_f(a0[1]);
                    y0[2] = x0[2] + bflo(ur.y) * sigmoid_f(a0[2]); y0[3] = x0[3] + bfhi(ur.y) * sigmoid_f(a0[3]);
                    y1[0] = x1[0] + bflo(ur.z) * sigmoid_f(a1[0]); y1[1] = x1[1] + bfhi(ur.z) * sigmoid_f(a1[1]);
                    y1[2] = x1[2] + bflo(ur.w) * sigmoid_f(a1[2]); y1[3] = x1[3] + bfhi(ur.w) * sigmoid_f(a1[3]);
                    *(f32x4*)(X + o) = y0; *(f32x4*)(X + o + 4) = y1;
                    store8bf(xb + o, y0, y1); __builtin_amdgcn_sched_barrier(0); }
        }
    }
};

struct Params {
    const float* in[26];
    float* out;
    unsigned char* ws;
    int ph_lo, ph_hi;
};
enum { I_X = 0, I_P, I_WIN, I_CONVW, I_CONVB, I_DTB, I_ALOG, I_DSKIP, I_NORMW, I_SCW, I_WOUT, I_WQKV, I_BQKV, I_SINK, I_WO, I_BO,
       I_LNMG, I_LNMB, I_WG, I_WU, I_WD, I_LNFG, I_LNFB, I_WPLE, I_WPG, I_BPG };

DI void tr_item(const float* W, int ldw, int k0, int src_col, int nvalid, bf16_t* WT, int K, int dst_row, LAS float* scr, int lane) {
    const int c = lane & 31;
#pragma unroll 8
    for (int i = 0; i < 32; ++i) { const int kk = 2 * i + (lane >> 5); scr[kk * 33 + c] = (c < nvalid) ? W[(size_t)(k0 + kk) * ldw + src_col + c] : 0.f; }
    asm volatile("s_waitcnt lgkmcnt(0)" ::: "memory");
    const int c8 = lane & 7;
#pragma unroll
    for (int j = 0; j < 4; ++j) { const int n = (lane >> 3) + 8 * j; const LAS float* s = scr + (8 * c8) * 33 + n;
        u32x4 o; o.x = pk2(s[0 * 33], s[1 * 33]); o.y = pk2(s[2 * 33], s[3 * 33]); o.z = pk2(s[4 * 33], s[5 * 33]); o.w = pk2(s[6 * 33], s[7 * 33]);
        *(u32x4*)(WT + (size_t)(dst_row + n) * K + k0 + 8 * c8) = o; }
    asm volatile("s_waitcnt lgkmcnt(0)" ::: "memory");
}

DI void cvt_rows_bf16(const float* src, bf16_t* dst, size_t n8, int gtid, int nthreads) {
    for (size_t i = gtid; i < n8; i += nthreads) {
        const f32x4 a = *(const f32x4*)(src + i * 8), b = *(const f32x4*)(src + i * 8 + 4);
        store8bf(dst + i * 8, a, b);
    }
}

DI void prologue_phase(const Params& p, LAS unsigned char* lds) {
    int tid_ = threadIdx.x; asm volatile("" : "+v"(tid_));
    const int tid = tid_, lane = tid & 63, wid = tid >> 6;
    LAS float* scr = (LAS float*)(lds + wid * 16384);
    const int gw = blockIdx.x * 8 + wid, NGW = gridDim.x * 8;
    unsigned char* ws = p.ws;
    constexpr int IT_IN = 16 * (N_IN / 32), IT_OUT = 32 * 32, IT_GU = 16 * (2 * DFF / 32), IT_DN = (DFF / 64) * 32, IT_PG = 16 * 32, IT_PL = 4 * 32, IT_QKV = 16 * (QKV / 32), IT_O = 16 * 32;
    constexpr int NITEMS = IT_IN + IT_OUT + 2 * (IT_GU + IT_DN + IT_PG + IT_PL) + IT_QKV + IT_O;
    for (int it = gw; it < NITEMS; it += NGW) {
        int r = it;
        if (r < IT_IN) {
            const int nblk = r % (N_IN / 32), kb = r / (N_IN / 32), d = nblk * 32; int src = 0, nv = 32;
            if (d < 1024) src = d; else if (d < 2048) src = 2576 + (d - 1024); else if (d < 3584) src = 1024 + (d - 2048);
            else if (d < 5632) { const int q = d - 3584, tile = q / 256, w = q % 256; src = (w < 128 ? 3600 : 4624) + 128 * tile + (w % 128); }
            else if (d == 5632) { src = 2560; nv = 16; } else { src = 0; nv = 0; }
            tr_item(p.in[I_WIN], MIX_IN, kb * 64, src, nv, (bf16_t*)(ws + WS_WIN), DM, d, scr, lane); continue; }
        r -= IT_IN;
        if (r < IT_OUT) { const int nblk = r % 32, kb = r / 32; tr_item(p.in[I_WOUT], DM, kb * 64, nblk * 32, 32, (bf16_t*)(ws + WS_WOUT), 2048, nblk * 32, scr, lane); continue; }
        r -= IT_OUT;
        bool done = false;
#pragma unroll
        for (int l = 0; l < 2; ++l) {
            if (done) break;
            if (r < IT_GU) { const int nblk = r % (2 * DFF / 32), kb = r / (2 * DFF / 32), d = nblk * 32, tile = d / 256, w = d % 256;
                const float* W = (w < 128 ? p.in[I_WG] : p.in[I_WU]) + (size_t)l * DM * DFF;
                tr_item(W, DFF, kb * 64, 128 * tile + (w % 128), 32, (bf16_t*)(ws + WS_WGU0 + l * SZ_WGU), DM, d, scr, lane); done = true; break; }
            r -= IT_GU;
            if (r < IT_DN) { const int nblk = r % 32, kb = r / 32; tr_item(p.in[I_WD] + (size_t)l * DFF * DM, DM, kb * 64, nblk * 32, 32, (bf16_t*)(ws + WS_WDN0 + l * SZ_WDN), DFF, nblk * 32, scr, lane); done = true; break; }
            r -= IT_DN;
            if (r < IT_PG) { const int nblk = r % 32, kb = r / 32; tr_item(p.in[I_WPG] + (size_t)l * DM * DM, DM, kb * 64, nblk * 32, 32, (bf16_t*)(ws + WS_WPG0 + l * SZ_WPG), DM, nblk * 32, scr, lane); done = true; break; }
            r -= IT_PG;
            if (r < IT_PL) { const int nblk = r % 32, kb = r / 32; tr_item(p.in[I_WPLE] + (size_t)l * PLE_DIM * DM, DM, kb * 64, nblk * 32, 32, (bf16_t*)(ws + WS_WPL0 + l * SZ_WPL), PLE_DIM, nblk * 32, scr, lane); done = true; break; }
            r -= IT_PL;
        }
        if (done) continue;
        if (r < IT_QKV) { const int nblk = r % (QKV / 32), kb = r / (QKV / 32); tr_item(p.in[I_WQKV], QKV, kb * 64, nblk * 32, 32, (bf16_t*)(ws + WS_WQKV), DM, nblk * 32, scr, lane); continue; }
        r -= IT_QKV;
        { const int nblk = r % 32, kb = r / 32; tr_item(p.in[I_WO], DM, kb * 64, nblk * 32, 32, (bf16_t*)(ws + WS_WO), DM, nblk * 32, scr, lane); }
    }
    cvt_rows_bf16(p.in[I_X], (bf16_t*)(ws + WS_XB), (size_t)M * DM / 8, blockIdx.x * NTHR + tid, gridDim.x * NTHR);
}

DI void conv8(const bf16_t* projb, int t, int ch, const float* cw, const float* cb, float (&o)[8]) {
    const f32x4 b0 = *(const f32x4*)(cb + ch), b1 = *(const f32x4*)(cb + ch + 4);
    float a[8] = {b0[0], b0[1], b0[2], b0[3], b1[0], b1[1], b1[2], b1[3]};
#pragma unroll
    for (int k = 0; k < 4; ++k) {
        const int tt = t - 3 + k;
        if (tt >= 0) {
            const u32x4 raw = *(const u32x4*)(projb + (size_t)tt * LDP + P_XBC + ch);
            const f32x4 w0 = *(const f32x4*)(cw + k * XBC + ch), w1 = *(const f32x4*)(cw + k * XBC + ch + 4);
            a[0] += w0[0] * bflo(raw.x); a[1] += w0[1] * bfhi(raw.x); a[2] += w0[2] * bflo(raw.y); a[3] += w0[3] * bfhi(raw.y);
            a[4] += w1[0] * bflo(raw.z); a[5] += w1[1] * bfhi(raw.z); a[6] += w1[2] * bflo(raw.w); a[7] += w1[3] * bfhi(raw.w);
        }
    }
#pragma unroll
    for (int j = 0; j < 8; ++j) o[j] = silu_f(a[j]);
}

constexpr int PT = 136;

DI void ssd_s1_phase(const Params& p, LAS unsigned char* lds) {
    int tid_ = threadIdx.x; asm volatile("" : "+v"(tid_));
    const int tid = tid_, lane = tid & 63, wid = tid >> 6, l32 = lane & 31, hh = lane >> 5;
    LAS bf16_t* BT = (LAS bf16_t*)lds;
    LAS bf16_t* XW = (LAS bf16_t*)(lds + 34816);
    LAS float* ACS = (LAS float*)(lds + 34816 + 2 * 17408);
    LAS float* DTS = ACS + 1024;
    const bf16_t* proj = (const bf16_t*)(p.ws + WS_PROJ);
    const float* dtraw = (const float*)(p.ws + WS_DTRAW);
    float* dtv = (float*)(p.ws + WS_DTV); float* acsg = (float*)(p.ws + WS_ACS); float* cdec = (float*)(p.ws + WS_CDEC);
    bf16_t* states = (bf16_t*)(p.ws + WS_XB);
    const float* cw = p.in[I_CONVW]; const float* cb = p.in[I_CONVB];
    for (int unit = blockIdx.x; unit < 256; unit += gridDim.x) {
        const int b = unit >> 5, c = (unit >> 1) & 15, g = unit & 1;
        const int t0 = c * 128, row0 = b * SEQ + t0;
        const bf16_t* projb = proj + (size_t)b * SEQ * LDP;
        {
            const int h = 8 * g + wid; const float bias = p.in[I_DTB][h], A = -expf(p.in[I_ALOG][h]);
            const int l0 = 2 * lane;
            const float x0 = dtraw[(size_t)(row0 + l0) * 16 + h] + bias, x1 = dtraw[(size_t)(row0 + l0 + 1) * 16 + h] + bias;
            const float d0 = x0 > 20.f ? x0 : log1pf(expf(x0)), d1 = x1 > 20.f ? x1 : log1pf(expf(x1));
            const float a0 = d0 * A, a1 = d1 * A, s = a0 + a1;
            float incl = s;
#pragma unroll
            for (int o = 1; o < 64; o <<= 1) { const float tv = __shfl_up(incl, o); if (lane >= o) incl += tv; }
            const float c0 = incl - s + a0, c1 = incl;
            ACS[wid * 128 + l0] = c0; ACS[wid * 128 + l0 + 1] = c1; DTS[wid * 128 + l0] = d0; DTS[wid * 128 + l0 + 1] = d1;
            acsg[(size_t)(row0 + l0) * 16 + h] = c0; acsg[(size_t)(row0 + l0 + 1) * 16 + h] = c1;
            dtv[(size_t)(row0 + l0) * 16 + h] = d0; dtv[(size_t)(row0 + l0 + 1) * 16 + h] = d1;
            if (lane == 63) cdec[(b * 16 + c) * 16 + h] = expf(c1);
        }
        for (int task = tid; task < 128 * 16; task += NTHR) {
            const int l = task & 127, cg8 = task >> 7; float v[8];
            conv8(projb, t0 + l, 1024 + 128 * g + 8 * cg8, cw, cb, v);
#pragma unroll
            for (int j = 0; j < 8; ++j) BT[(8 * cg8 + j) * PT + l] = f2bf(v[j]);
        }
        __syncthreads();
        for (int r = 0; r < 8; ++r) {
            const int h = 8 * g + r;
            LAS bf16_t* buf = XW + (r & 1) * 64 * PT;
            const float alast = ACS[r * 128 + 127];
            for (int task = tid; task < 128 * 8; task += NTHR) {
                const int l = task & 127, cg8 = task >> 7; float v[8];
                conv8(projb, t0 + l, 64 * h + 8 * cg8, cw, cb, v);
                const float sc = DTS[r * 128 + l] * __expf(alast - ACS[r * 128 + l]);
#pragma unroll
                for (int j = 0; j < 8; ++j) buf[(8 * cg8 + j) * PT + l] = f2bf(v[j] * sc);
            }
            __syncthreads();
            const int pb = wid >> 2, nb = wid & 3;
            f32x16 acc = zero16();
#pragma unroll
            for (int t = 0; t < 8; ++t) {
                const bf16x8 a = *(const LAS bf16x8*)(buf + (pb * 32 + l32) * PT + 16 * t + 8 * hh);
                const bf16x8 bb = *(const LAS bf16x8*)(BT + (nb * 32 + l32) * PT + 16 * t + 8 * hh);
                acc = MFMA32(a, bb, acc);
            }
            bf16_t* sp = states + ((size_t)((b * 16 + c) * 16 + h) * 64) * 128;
#pragma unroll
            for (int i = 0; i < 16; ++i) sp[(size_t)(pb * 32 + crow(i, hh)) * 128 + nb * 32 + l32] = f2bf(acc[i]);
        }
        __syncthreads();
    }
}

DI void ssd_scan_phase(const Params& p) {
    bf16_t* states = (bf16_t*)(p.ws + WS_XB); const float* cdec = (const float*)(p.ws + WS_CDEC);
    const int total = NBATCH * 16 * 64 * 16;
    for (int idx = blockIdx.x * NTHR + threadIdx.x; idx < total; idx += gridDim.x * NTHR) {
        const int n8 = idx & 15, pp = (idx >> 4) & 63, h = (idx >> 10) & 15, b = idx >> 14;
        float st[8] = {0.f, 0.f, 0.f, 0.f, 0.f, 0.f, 0.f, 0.f};
        for (int c = 0; c < 16; ++c) {
            bf16_t* ptr = states + ((size_t)(((b * 16 + c) * 16 + h) * 64 + pp)) * 128 + n8 * 8;
            const u32x4 raw = *(const u32x4*)ptr; const float dec = cdec[(b * 16 + c) * 16 + h];
            u32x4 o; o.x = pk2(st[0], st[1]); o.y = pk2(st[2], st[3]); o.z = pk2(st[4], st[5]); o.w = pk2(st[6], st[7]);
            *(u32x4*)ptr = o;
            st[0] = st[0] * dec + bflo(raw.x); st[1] = st[1] * dec + bfhi(raw.x); st[2] = st[2] * dec + bflo(raw.y); st[3] = st[3] * dec + bfhi(raw.y);
            st[4] = st[4] * dec + bflo(raw.z); st[5] = st[5] * dec + bfhi(raw.z); st[6] = st[6] * dec + bflo(raw.w); st[7] = st[7] * dec + bfhi(raw.w);
        }
    }
}

DI void ssd_s3_phase(const Params& p, LAS unsigned char* lds) {
    int tid_ = threadIdx.x; asm volatile("" : "+v"(tid_));
    const int tid = tid_, lane = tid & 63, wid = tid >> 6, l32 = lane & 31, hh = lane >> 5;
    LAS bf16_t* CS = (LAS bf16_t*)lds;
    LAS bf16_t* BS = (LAS bf16_t*)(lds + 34816);
    LAS bf16_t* XT = (LAS bf16_t*)(lds + 69632);
    LAS bf16_t* HS = (LAS bf16_t*)(lds + 87040);
    LAS float* ACS = (LAS float*)(lds + 104448);
    LAS float* DTS = ACS + 1024;
    bf16_t* proj = (bf16_t*)(p.ws + WS_PROJ);
    const float* dtv = (const float*)(p.ws + WS_DTV); const float* acsg = (const float*)(p.ws + WS_ACS);
    const bf16_t* states = (const bf16_t*)(p.ws + WS_XB);
    float* ssb = (float*)(p.ws + WS_SS);
    const float* cw = p.in[I_CONVW]; const float* cb = p.in[I_CONVB];
    for (int unit = blockIdx.x; unit < 256; unit += gridDim.x) {
        const int b = unit >> 5, c = (unit >> 1) & 15, g = unit & 1;
        const int t0 = c * 128, row0 = b * SEQ + t0;
        const bf16_t* projb = proj + (size_t)b * SEQ * LDP;
        __syncthreads();
        for (int i = tid; i < 1024; i += NTHR) { const int l = i >> 3, r = i & 7;
            ACS[r * 128 + l] = acsg[(size_t)(row0 + l) * 16 + 8 * g + r]; DTS[r * 128 + l] = dtv[(size_t)(row0 + l) * 16 + 8 * g + r]; }
        for (int task = tid; task < 128 * 32; task += NTHR) {
            const int cg = task & 31, l = task >> 5; float v[8];
            const int ch = (cg < 16) ? (1024 + 128 * g + 8 * cg) : (1280 + 128 * g + 8 * (cg - 16));
            conv8(projb, t0 + l, ch, cw, cb, v);
            u32x4 o; o.x = pk2(v[0], v[1]); o.y = pk2(v[2], v[3]); o.z = pk2(v[4], v[5]); o.w = pk2(v[6], v[7]);
            LAS bf16_t* dst = (cg < 16) ? (BS + l * PT + 8 * cg) : (CS + l * PT + 8 * (cg - 16));
            *(LAS u32x4*)dst = o;
        }
        __syncthreads();
        const int pb = wid >> 2, lb = wid & 3;
        f32x16 cbt[4];
#pragma unroll
        for (int sb = 0; sb < 4; ++sb) {
            cbt[sb] = zero16();
            if (sb <= lb) {
#pragma unroll
                for (int t = 0; t < 8; ++t) {
                    const bf16x8 a = *(const LAS bf16x8*)(BS + (sb * 32 + l32) * PT + 16 * t + 8 * hh);
                    const bf16x8 bb = *(const LAS bf16x8*)(CS + (lb * 32 + l32) * PT + 16 * t + 8 * hh);
                    cbt[sb] = MFMA32(a, bb, cbt[sb]);
                }
            }
        }
        for (int r = 0; r < 8; ++r) {
            const int h = 8 * g + r;
            __syncthreads();
            for (int task = tid; task < 128 * 8; task += NTHR) {
                const int l = task & 127, cg8 = task >> 7; float v[8];
                conv8(projb, t0 + l, 64 * h + 8 * cg8, cw, cb, v);
#pragma unroll
                for (int j = 0; j < 8; ++j) XT[(8 * cg8 + j) * PT + l] = f2bf(v[j]);
            }
            {
                const bf16_t* sp = states + ((size_t)((b * 16 + c) * 16 + h) * 64) * 128;
                for (int ck = tid; ck < 1024; ck += NTHR) { const int pp = ck >> 4, n8 = ck & 15;
                    *(LAS u32x4*)(HS + pp * PT + 8 * n8) = *(const u32x4*)(sp + pp * 128 + 8 * n8); }
            }
            __syncthreads();
            const float acs_l = ACS[r * 128 + lb * 32 + l32];
            const float dsk = p.in[I_DSKIP][h];
            f32x16 yd = zero16(), yo = zero16();
#pragma unroll
            for (int sb = 0; sb < 4; ++sb) {
                if (sb <= lb) {
                    float lt[16];
#pragma unroll
                    for (int i4 = 0; i4 < 4; ++i4) {
                        const int s0 = sb * 32 + 8 * i4 + 4 * hh;
                        const f32x4 as = *(const LAS f32x4*)(ACS + r * 128 + s0), ds = *(const LAS f32x4*)(DTS + r * 128 + s0);
#pragma unroll
                        for (int j = 0; j < 4; ++j) {
                            float v = cbt[sb][4 * i4 + j] * __expf(fminf(acs_l - as[j], 0.f)) * ds[j];
                            if (sb == lb) { const int sl = 8 * i4 + 4 * hh + j; if (sl > l32) v = 0.f; if (sl == l32) v += dsk; }
                            lt[4 * i4 + j] = v;
                        }
                    }
#pragma unroll
                    for (int t = 0; t < 2; ++t) {
                        const bf16x8 bfrag = pack8(lt[8 * t], lt[8 * t + 1], lt[8 * t + 2], lt[8 * t + 3], lt[8 * t + 4], lt[8 * t + 5], lt[8 * t + 6], lt[8 * t + 7]);
                        const LAS bf16_t* ap = XT + (pb * 32 + l32) * PT + sb * 32 + 16 * t + 4 * hh;
                        const bf16x8 afrag = cat4(*(const LAS s16x4*)ap, *(const LAS s16x4*)(ap + 8));
                        yd = MFMA32(afrag, bfrag, yd);
                    }
                }
            }
#pragma unroll
            for (int t = 0; t < 8; ++t) {
                const bf16x8 a = *(const LAS bf16x8*)(HS + (pb * 32 + l32) * PT + 16 * t + 8 * hh);
                const bf16x8 bb = *(const LAS bf16x8*)(CS + (lb * 32 + l32) * PT + 16 * t + 8 * hh);
                yo = MFMA32(a, bb, yo);
            }
            const float el = __expf(acs_l);
            const int rowg = row0 + lb * 32 + l32;
            float ssq = 0.f;
#pragma unroll
            for (int i4 = 0; i4 < 4; ++i4) {
                bf16_t* zp = proj + (size_t)rowg * LDP + P_Z + 64 * h + pb * 32 + 8 * i4 + 4 * hh;
                const u32x2 zr = *(const u32x2*)zp;
                const float y0 = (yd[4 * i4 + 0] + el * yo[4 * i4 + 0]) * silu_f(bflo(zr.x));
                const float y1 = (yd[4 * i4 + 1] + el * yo[4 * i4 + 1]) * silu_f(bfhi(zr.x));
                const float y2 = (yd[4 * i4 + 2] + el * yo[4 * i4 + 2]) * silu_f(bflo(zr.y));
                const float y3 = (yd[4 * i4 + 3] + el * yo[4 * i4 + 3]) * silu_f(bfhi(zr.y));
                ssq += y0 * y0 + y1 * y1 + y2 * y2 + y3 * y3;
                u32x2 o; o.x = pk2(y0, y1); o.y = pk2(y2, y3); *(u32x2*)zp = o;
            }
            ssq += __shfl_xor(ssq, 32);
            if (hh == 0) ssb[(size_t)rowg * 32 + 2 * h + pb] = ssq;
        }
    }
}

DI void ssd_e_phase(const Params& p) {
    int tid_ = threadIdx.x; asm volatile("" : "+v"(tid_));
    const int tid = tid_, lane = tid & 63, wid = tid >> 6;
    bf16_t* proj = (bf16_t*)(p.ws + WS_PROJ); const float* ssb = (const float*)(p.ws + WS_SS);
    const float* nw = p.in[I_NORMW]; const float* scw = p.in[I_SCW];
    for (int row = blockIdx.x * 8 + wid; row < M; row += gridDim.x * 8) {
        const int t = row & (SEQ - 1);
        float v = lane < 32 ? ssb[(size_t)row * 32 + lane] : 0.f;
        v += __shfl_xor(v, 1); v += __shfl_xor(v, 2); v += __shfl_xor(v, 4); v += __shfl_xor(v, 8);
        const float rs0 = rsqrtf(__shfl(v, 0) * (1.f / 512.f) + RMS_EPS), rs1 = rsqrtf(__shfl(v, 16) * (1.f / 512.f) + RMS_EPS);
        bf16_t* pr = proj + (size_t)row * LDP;
#pragma unroll
        for (int k = 0; k < 2; ++k) {
            const int ch = 512 * k + 8 * lane; const float rs = k ? rs1 : rs0;
            const u32x4 raw = *(const u32x4*)(pr + P_Z + ch);
            const f32x4 w0 = *(const f32x4*)(nw + ch), w1 = *(const f32x4*)(nw + ch + 4);
            u32x4 o;
            o.x = pk2(bflo(raw.x) * rs * w0[0], bfhi(raw.x) * rs * w0[1]); o.y = pk2(bflo(raw.y) * rs * w0[2], bfhi(raw.y) * rs * w0[3]);
            o.z = pk2(bflo(raw.z) * rs * w1[0], bfhi(raw.z) * rs * w1[1]); o.w = pk2(bflo(raw.w) * rs * w1[2], bfhi(raw.w) * rs * w1[3]);
            *(u32x4*)(pr + P_Z + ch) = o;
        }
#pragma unroll
        for (int k = 0; k < 2; ++k) {
            const int ch = 512 * k + 8 * lane;
            float a[8] = {0.f, 0.f, 0.f, 0.f, 0.f, 0.f, 0.f, 0.f};
#pragma unroll
            for (int kk = 0; kk < 3; ++kk) {
                const int tt = t - 2 + kk;
                if (tt >= 0) {
                    const u32x4 raw = *(const u32x4*)(pr + (ptrdiff_t)(kk - 2) * LDP + P_PROD + ch);
                    const f32x4 w0 = *(const f32x4*)(scw + kk * 1024 + ch), w1 = *(const f32x4*)(scw + kk * 1024 + ch + 4);
                    a[0] += w0[0] * bflo(raw.x); a[1] += w0[1] * bfhi(raw.x); a[2] += w0[2] * bflo(raw.y); a[3] += w0[3] * bfhi(raw.y);
                    a[4] += w1[0] * bflo(raw.z); a[5] += w1[1] * bfhi(raw.z); a[6] += w1[2] * bflo(raw.w); a[7] += w1[3] * bfhi(raw.w);
                }
            }
            const u32x4 sb = *(const u32x4*)(pr + P_SCB + ch);
            u32x4 o;
            o.x = pk2(bflo(sb.x) * a[0], bfhi(sb.x) * a[1]); o.y = pk2(bflo(sb.y) * a[2], bfhi(sb.y) * a[3]);
            o.z = pk2(bflo(sb.z) * a[4], bfhi(sb.z) * a[5]); o.w = pk2(bflo(sb.w) * a[6], bfhi(sb.w) * a[7]);
            *(u32x4*)(pr + P_SCB + ch) = o;
        }
    }
}

DI void ln_phase(const Params& p, const float* gam, const float* bet, const float* psrc) {
    int tid_ = threadIdx.x; asm volatile("" : "+v"(tid_));
    const int tid = tid_, lane = tid & 63, wid = tid >> 6;
    float* X = p.out; bf16_t* xb = (bf16_t*)(p.ws + WS_XB);
    for (int row = blockIdx.x * 8 + wid; row < M; row += gridDim.x * 8) {
        f32x4* xr = (f32x4*)(X + (size_t)row * DM) + lane;
        f32x4 v[4]; float s = 0.f;
#pragma unroll
        for (int j = 0; j < 4; ++j) { v[j] = xr[64 * j]; s += (v[j][0] + v[j][1]) + (v[j][2] + v[j][3]); }
#pragma unroll
        for (int o = 1; o < 64; o <<= 1) s += __shfl_xor(s, o);
        const float mean = s * (1.f / DM); float s2 = 0.f;
#pragma unroll
        for (int j = 0; j < 4; ++j) { v[j] = v[j] - mean; s2 += (v[j][0] * v[j][0] + v[j][1] * v[j][1]) + (v[j][2] * v[j][2] + v[j][3] * v[j][3]); }
#pragma unroll
        for (int o = 1; o < 64; o <<= 1) s2 += __shfl_xor(s2, o);
        const float rstd = rsqrtf(s2 * (1.f / DM) + LN_EPS);
        u32x2* ob = (u32x2*)(xb + (size_t)row * DM) + lane;
#pragma unroll
        for (int j = 0; j < 4; ++j) {
            const f32x4 gv = *((const f32x4*)gam + lane + 64 * j), bv = *((const f32x4*)bet + lane + 64 * j);
            const f32x4 y = v[j] * rstd * gv + bv;
            xr[64 * j] = y;
            u32x2 o; o.x = pk2(y[0], y[1]); o.y = pk2(y[2], y[3]); ob[64 * j] = o;
        }
    }
    if (psrc) cvt_rows_bf16(psrc, (bf16_t*)(p.ws + WS_PB), (size_t)M * PLE_DIM / 8, blockIdx.x * NTHR + tid, gridDim.x * NTHR);
}

DI void attn_phase(const Params& p, LAS unsigned char* lds) {
    int tid_ = threadIdx.x; asm volatile("" : "+v"(tid_));
    const int tid = tid_, lane = tid & 63, wid = tid >> 6, l32 = lane & 31, hh = lane >> 5;
    constexpr int KP = 72, VP = 264;
    LAS bf16_t* KS = (LAS bf16_t*)lds;
    LAS bf16_t* VT = (LAS bf16_t*)(lds + 36864);
    const bf16_t* qkv = (const bf16_t*)(p.ws + WS_QKVB); bf16_t* ob = (bf16_t*)(p.ws + WS_OB);
    for (int unit = blockIdx.x; unit < 512; unit += gridDim.x) {
        const int b = unit >> 6, nb = (unit >> 2) & 15, kvh = unit & 3;
        __syncthreads();
        for (int id = tid; id < 2048; id += NTHR) {
            const int s = id >> 3, c8 = id & 7; u32x4 v = {0u, 0u, 0u, 0u};
            if (nb > 0 || s >= 128) v = *(const u32x4*)(qkv + (size_t)(b * SEQ + (nb - 1) * 128 + s) * QKV + 1024 + 64 * kvh + 8 * c8);
            *(LAS u32x4*)(KS + s * KP + 8 * c8) = v;
        }
        for (int id = tid; id < 2048; id += NTHR) {
            const int s = id & 255, c8 = id >> 8; u32x4 v = {0u, 0u, 0u, 0u};
            if (nb > 0 || s >= 128) v = *(const u32x4*)(qkv + (size_t)(b * SEQ + (nb - 1) * 128 + s) * QKV + 1280 + 64 * kvh + 8 * c8);
            LAS bf16_t* d = VT + (8 * c8) * VP + s;
            d[0 * VP] = (bf16_t)(v.x & 0xffffu); d[1 * VP] = (bf16_t)(v.x >> 16); d[2 * VP] = (bf16_t)(v.y & 0xffffu); d[3 * VP] = (bf16_t)(v.y >> 16);
            d[4 * VP] = (bf16_t)(v.z & 0xffffu); d[5 * VP] = (bf16_t)(v.z >> 16); d[6 * VP] = (bf16_t)(v.w & 0xffffu); d[7 * VP] = (bf16_t)(v.w >> 16);
        }
        __syncthreads();
        const int gq = wid >> 1, qhalf = wid & 1, h = kvh * 4 + gq;
        const float sink = p.in[I_SINK][h];
#pragma unroll 1
        for (int qq = 0; qq < 2; ++qq) {
            const int qb = 2 * qhalf + qq, q = 32 * qb + l32;
            const size_t qrow = (size_t)(b * SEQ + nb * 128 + q);
            bf16x8 qf[4];
#pragma unroll
            for (int t = 0; t < 4; ++t) qf[t] = *(const bf16x8*)(qkv + qrow * QKV + 64 * h + 16 * t + 8 * hh);
            f32x16 st[5];
#pragma unroll
            for (int kk = 0; kk < 5; ++kk) {
                st[kk] = zero16();
#pragma unroll
                for (int t = 0; t < 4; ++t) {
                    const bf16x8 a = *(const LAS bf16x8*)(KS + (32 * (qb + kk) + l32) * KP + 16 * t + 8 * hh);
                    st[kk] = MFMA32(a, qf[t], st[kk]);
                }
            }
            float mx = sink;
#pragma unroll
            for (int kk = 0; kk < 5; ++kk)
#pragma unroll
                for (int i = 0; i < 16; ++i) {
                    const int s = 32 * (qb + kk) + crow(i, hh);
                    const bool valid = (s > q) && (s <= q + 128) && (nb > 0 || s >= 128);
                    const float v = valid ? st[kk][i] * 0.125f : -INFINITY;
                    st[kk][i] = v; mx = fmaxf(mx, v);
                }
            mx = fmaxf(mx, __shfl_xor(mx, 32));
            float sum = 0.f;
#pragma unroll
            for (int kk = 0; kk < 5; ++kk)
#pragma unroll
                for (int i = 0; i < 16; ++i) { const float e = __expf(st[kk][i] - mx); st[kk][i] = e; sum += e; }
            sum += __shfl_xor(sum, 32);
            sum += __expf(sink - mx);
            const float inv = 1.f / sum;
            f32x16 ot[2]; ot[0] = zero16(); ot[1] = zero16();
#pragma unroll
            for (int kk = 0; kk < 5; ++kk)
#pragma unroll
                for (int t = 0; t < 2; ++t) {
                    const bf16x8 bfrag = pack8(st[kk][8 * t], st[kk][8 * t + 1], st[kk][8 * t + 2], st[kk][8 * t + 3], st[kk][8 * t + 4], st[kk][8 * t + 5], st[kk][8 * t + 6], st[kk][8 * t + 7]);
#pragma unroll
                    for (int db = 0; db < 2; ++db) {
                        const LAS bf16_t* ap = VT + (32 * db + l32) * VP + 32 * (qb + kk) + 16 * t + 4 * hh;
                        const bf16x8 afrag = cat4(*(const LAS s16x4*)ap, *(const LAS s16x4*)(ap + 8));
                        ot[db] = MFMA32(afrag, bfrag, ot[db]);
                    }
                }
#pragma unroll
            for (int db = 0; db < 2; ++db)
#pragma unroll
                for (int i4 = 0; i4 < 4; ++i4) {
                    u32x2 o; o.x = pk2(ot[db][4 * i4] * inv, ot[db][4 * i4 + 1] * inv); o.y = pk2(ot[db][4 * i4 + 2] * inv, ot[db][4 * i4 + 3] * inv);
                    *(u32x2*)(ob + qrow * DM + 64 * h + 32 * db + 8 * i4 + 4 * hh) = o;
                }
        }
    }
}

#define XB_TMO      128
#define XB_XCNT(j)  (256  + 64 * (j))
#define XB_XSUB(j)  (1280 + 64 * (j))
#define XB_XGEN(j)  (2304 + 64 * (j))
#define XB_TOP      3328
#define XB_TOPGEN   3392
#define XCD_BAR_WORDS 3456
#define XB_SPIN_CAP (1u << 20)
DI unsigned xb_ld(unsigned* p)              { return __hip_atomic_load(p, __ATOMIC_RELAXED, __HIP_MEMORY_SCOPE_AGENT); }
DI unsigned xb_add(unsigned* p, unsigned v) { return __hip_atomic_fetch_add(p, v, __ATOMIC_RELAXED, __HIP_MEMORY_SCOPE_AGENT); }
DI unsigned xb_xcc_id() { return (unsigned)__builtin_amdgcn_s_getreg((3 << 11) | 20) & 0xFu; }
#define XB_SPIN(cond, bar) do { unsigned _sp = 0; while (cond) { __builtin_amdgcn_s_sleep(1); \
    if ((++_sp & 255u) == 0u) { if (xb_ld(&(bar)[XB_TMO])) break; if (_sp > XB_SPIN_CAP) { atomicAdd(&(bar)[XB_TMO], 1u); break; } } } } while (0)
struct XcdBarrier { unsigned* bar; unsigned x; volatile LAS unsigned* st; };
DI XcdBarrier xcd_barrier_post(unsigned* bar, volatile LAS unsigned* st) {
    XcdBarrier b; b.bar = bar; b.x = xb_xcc_id(); b.st = st;
    if (threadIdx.x == 0) (void)xb_add(&bar[XB_XCNT(b.x)], 1u);
    return b;
}
DI void xcd_barrier_complete(unsigned* bar, unsigned x, unsigned& nloc, unsigned& nx) {
    const unsigned G = gridDim.x * gridDim.y * gridDim.z;
    unsigned sum, cnt, mine, sp = 0u;
    for (;;) {
        sum = 0u; cnt = 0u; mine = 0u;
#pragma unroll
        for (unsigned j = 0; j < 16; ++j) { const unsigned c = xb_ld(&bar[XB_XCNT(j)]); sum += c; cnt += (c > 0u) ? 1u : 0u; mine = (j == x) ? c : mine; }
        if (sum == G) break;
        __builtin_amdgcn_s_sleep(1);
        if ((++sp & 255u) == 0u) { if (xb_ld(&bar[XB_TMO])) break; if (sp > XB_SPIN_CAP) { atomicAdd(&bar[XB_TMO], 1u); break; } }
    }
    nloc = mine > 0u ? mine : 1u; nx = cnt > 0u ? cnt : 1u;
}
DI void xcd_barrier(const XcdBarrier& b) {
    asm volatile("s_waitcnt vmcnt(0)" ::: "memory");
    __syncthreads();
    if (threadIdx.x == 0) {
        unsigned* bar = b.bar;
        __builtin_amdgcn_s_waitcnt(0);
        unsigned nloc = b.st[0], nx = b.st[1];
        if (nloc == 0u) { xcd_barrier_complete(bar, b.x, nloc, nx); b.st[0] = nloc; b.st[1] = nx; }
        const unsigned old = xb_add(&bar[XB_XSUB(b.x)], 1u);
        const unsigned gen = old / nloc;
        if (old + 1u == (gen + 1u) * nloc) {
            __builtin_amdgcn_fence(__ATOMIC_RELEASE, "agent");
            asm volatile("s_waitcnt vmcnt(0)" ::: "memory");
            const unsigned og = xb_add(&bar[XB_TOP], 1u);
            const unsigned tg = og / nx;
            if (og + 1u == (tg + 1u) * nx) xb_add(&bar[XB_TOPGEN], 1u);
            else XB_SPIN(xb_ld(&bar[XB_TOPGEN]) == tg, bar);
            __builtin_amdgcn_fence(__ATOMIC_ACQUIRE, "agent");
            xb_add(&bar[XB_XGEN(b.x)], 1u);
            asm volatile("s_waitcnt vmcnt(0)" ::: "memory");
        } else {
            XB_SPIN(xb_ld(&bar[XB_XGEN(b.x)]) == gen, bar);
            __builtin_amdgcn_fence(__ATOMIC_ACQUIRE, "agent");
            asm volatile("s_waitcnt vmcnt(0)" ::: "memory");
        }
    }
    __syncthreads();
}

__global__ void __launch_bounds__(NTHR) fwd_megakernel(Params p) {
    extern __shared__ __attribute__((aligned(16))) unsigned char smem[];
    LAS unsigned char* lds = (LAS unsigned char*)smem;
    cg::grid_group grid = cg::this_grid();
    unsigned char* ws = p.ws;
    const int G = gridDim.x, bid = blockIdx.x;
    volatile LAS unsigned* bst = (volatile LAS unsigned*)(lds + LDS_STAGE);
    if (threadIdx.x < 16) bst[threadIdx.x] = 0u;
    __syncthreads();
    const XcdBarrier xbar = xcd_barrier_post((unsigned*)(ws + WS_CTL), bst);
    int ph = 0;
#define PHASE_BEGIN if (ph >= p.ph_lo && ph < p.ph_hi) {
#define PHASE_END   if (ph + 1 < p.ph_hi) { if (ph == 0) grid.sync(); else xcd_barrier(xbar); } } ++ph;

    PHASE_BEGIN prologue_phase(p, lds); PHASE_END
    PHASE_BEGIN {
        pg8::Gemm g{(const bf16_t*)(ws + WS_XB), (const bf16_t*)(ws + WS_WIN), M, N_IN, DM, DM}; pg8::StaticOrder S; S.init(M, N_IN, G, bid);
        EpiIn E{(bf16_t*)(ws + WS_PROJ), (float*)(ws + WS_DTRAW)};
        pg8::gemm_phase(lds, g, S, E);
    } PHASE_END
    PHASE_BEGIN ssd_s1_phase(p, lds); PHASE_END
    PHASE_BEGIN ssd_scan_phase(p); PHASE_END
    PHASE_BEGIN ssd_s3_phase(p, lds); PHASE_END
    PHASE_BEGIN ssd_e_phase(p); PHASE_END
    PHASE_BEGIN {
        pg8::Gemm g{(const bf16_t*)(ws + WS_PROJ), (const bf16_t*)(ws + WS_WOUT), M, DM, 2048, LDP}; pg8::StaticOrder S; S.init(M, DM, G, bid);
        EpiRes E{p.in[I_X], p.out, nullptr};
        pg8::gemm_phase(lds, g, S, E);
    } PHASE_END
#pragma unroll 1
    for (int layer = 0; layer < 2; ++layer) {
        if (layer == 1) {
            PHASE_BEGIN {
                pg8::Gemm g{(const bf16_t*)(ws + WS_XB), (const bf16_t*)(ws + WS_WQKV), M, QKV, DM, DM}; pg8::StaticOrder S; S.init(M, QKV, G, bid);
                EpiBf E{(bf16_t*)(ws + WS_QKVB), QKV, p.in[I_BQKV]};
                pg8::gemm_phase(lds, g, S, E);
            } PHASE_END
            PHASE_BEGIN attn_phase(p, lds); PHASE_END
            PHASE_BEGIN {
                pg8::Gemm g{(const bf16_t*)(ws + WS_OB), (const bf16_t*)(ws + WS_WO), M, DM, DM, DM}; pg8::StaticOrder S; S.init(M, DM, G, bid);
                EpiRes E{p.out, p.out, p.in[I_BO]};
                pg8::gemm_phase(lds, g, S, E);
            } PHASE_END
        }
        PHASE_BEGIN ln_phase(p, p.in[I_LNMG] + layer * DM, p.in[I_LNMB] + layer * DM, p.in[I_P] + (size_t)layer * M * PLE_DIM); PHASE_END
        PHASE_BEGIN {
            {
                pg8::Gemm g{(const bf16_t*)(ws + WS_XB), (const bf16_t*)(ws + WS_WGU0 + layer * SZ_WGU), M, 2 * DFF, DM, DM}; pg8::StaticOrder S; S.init(M, 2 * DFF, G, bid);
                EpiGlu E{(bf16_t*)(ws + WS_H)};
                pg8::gemm_phase(lds, g, S, E);
            }
            {
                pg8::Gemm g{(const bf16_t*)(ws + WS_PB), (const bf16_t*)(ws + WS_WPL0 + layer * SZ_WPL), M, DM, PLE_DIM, PLE_DIM}; pg8::StaticOrder S; S.init(M, DM, G, bid);
                EpiBf E{(bf16_t*)(ws + WS_U), DM, nullptr};
                pg8::gemm_phase(lds, g, S, E);
            }
        } PHASE_END
        PHASE_BEGIN {
            pg8::Gemm g{(const bf16_t*)(ws + WS_H), (const bf16_t*)(ws + WS_WDN0 + layer * SZ_WDN), M, DM, DFF, DFF}; pg8::StaticOrder S; S.init(M, DM, G, bid);
            EpiRes E{p.out, p.out, nullptr};
            pg8::gemm_phase(lds, g, S, E);
        } PHASE_END
        PHASE_BEGIN ln_phase(p, p.in[I_LNFG] + layer * DM, p.in[I_LNFB] + layer * DM, nullptr); PHASE_END
        PHASE_BEGIN {
            pg8::Gemm g{(const bf16_t*)(ws + WS_XB), (const bf16_t*)(ws + WS_WPG0 + layer * SZ_WPG), M, DM, DM, DM}; pg8::StaticOrder S; S.init(M, DM, G, bid);
            EpiPle E{p.out, (const bf16_t*)(ws + WS_U), p.in[I_BPG] + layer * DM, (bf16_t*)(ws + WS_XB)};
            pg8::gemm_phase(lds, g, S, E);
        } PHASE_END
    }
#undef PHASE_BEGIN
#undef PHASE_END
}

constexpr int N_PHASES = 7 + 5 + 3 + 5;

extern "C" void kernel_launch(void* const* d_in, const int* in_sizes, int n_in, void* d_out, int out_size, void* d_ws, size_t ws_size, hipStream_t stream) {
    static int grid = 0;
    if (grid == 0) {
        if (n_in != 26 || out_size != M * DM || ws_size < WS_END) { fprintf(stderr, "kernel_launch: unexpected shapes: n_in %d out %d ws %zu (need %zu)\n", n_in, out_size, ws_size, (size_t)WS_END); grid = -1; return; }
        int dev = 0, cus = 0, per_cu = 0;
        hipGetDevice(&dev);
        hipDeviceGetAttribute(&cus, hipDeviceAttributeMultiprocessorCount, dev);
        hipFuncSetAttribute((const void*)fwd_megakernel, hipFuncAttributeMaxDynamicSharedMemorySize, LDS_BYTES);
        hipOccupancyMaxActiveBlocksPerMultiprocessor(&per_cu, (const void*)fwd_megakernel, NTHR, LDS_BYTES);
        if (per_cu < 1) { fprintf(stderr, "kernel_launch: occupancy query says %d blocks/CU\n", per_cu); per_cu = 1; }
        (void)hipGetLastError();
        grid = cus;
    }
    if (grid < 0) return;
    if (hipMemsetAsync((char*)d_ws + WS_CTL, 0, CTL_BYTES, stream) != hipSuccess) { fprintf(stderr, "kernel_launch: memset failed\n"); return; }
    Params p{};
    for (int i = 0; i < 26; ++i) p.in[i] = (const float*)d_in[i];
    p.out = (float*)d_out; p.ws = (unsigned char*)d_ws; p.ph_lo = 0; p.ph_hi = N_PHASES;
    void* args[] = {&p};
    hipError_t e = hipLaunchCooperativeKernel((const void*)fwd_megakernel, dim3(grid), dim3(NTHR), args, LDS_BYTES, stream);
    if (e != hipSuccess) fprintf(stderr, "cooperative launch failed: %s (grid %d)\n", hipGetErrorString(e), grid);
}
```
